# Optimizing an MI355X kernel written in HIP

```python
import math
import jax, jax.numpy as jnp
from jax import lax
import numpy as np

D_MODEL = 1024
BATCH = 16
SEQ = 2048
DEPTH = 2

CTX_LEN = 256
GRID_W = 64
EPS = 1e-6

ATT_HEADS = 8
ATT_HEAD_DIM = 64
ATT_V_DIM = 2 * ATT_HEAD_DIM
ATT_QK_WIDTH = ATT_HEADS * 2 * ATT_HEAD_DIM
ATT_WIDTH = ATT_HEADS * ATT_V_DIM
Q_BLOCK = 128
ROPE_BASE = 10000.0

REC_HEADS = 8
REC_KEY_DIM = 128
REC_VAL_DIM = D_MODEL // REC_HEADS
REC_KEY_WIDTH = REC_HEADS * REC_KEY_DIM
REC_WIDTH = REC_HEADS * REC_VAL_DIM
CHUNK = 64

SPLITS = (ATT_QK_WIDTH, ATT_QK_WIDTH, ATT_WIDTH, REC_KEY_WIDTH, REC_KEY_WIDTH, REC_KEY_WIDTH, REC_WIDTH, REC_WIDTH, D_MODEL, D_MODEL)
N_IN = sum(SPLITS)

N_EXPERTS = 16
N_GROUPS = 4
EXPERTS_PER_GROUP = N_EXPERTS // N_GROUPS
TOP_K = 2
D_EXPERT = 1024

kernel_name = 'hybrid_diffattn_hgrn2_groupmoe_dit'


def rmsnorm(x, g):
    xf = x.astype(jnp.float32)
    y = xf * lax.rsqrt(jnp.mean(xf * xf, axis=-1, keepdims=True) + EPS)
    return (y * g.astype(jnp.float32)).astype(x.dtype)


def modulate(x, shift, scale):
    return x * (1 + scale) + shift


def project(h, w):
    outs, start = [], 0
    for width in SPLITS:
        outs.append(h @ w[:, start:start + width])
        start += width
    return outs


def axial_angles(n_tok):
    rows = n_tok // GRID_W
    row = jnp.repeat(jnp.arange(rows, dtype=jnp.float32), GRID_W)
    col = jnp.tile(jnp.arange(GRID_W, dtype=jnp.float32), rows)
    n_freq = ATT_HEAD_DIM // 4
    inv = ROPE_BASE ** (-jnp.arange(n_freq, dtype=jnp.float32) / n_freq)
    return row[:, None] * inv, col[:, None] * inv


def _rotate(x, ang):
    x1, x2 = jnp.split(x, 2, axis=-1)
    cos, sin = jnp.cos(ang), jnp.sin(ang)
    return jnp.concatenate([x1 * cos - x2 * sin, x1 * sin + x2 * cos], axis=-1)


def axial_rope(x, ang_r, ang_c):
    xf = x.astype(jnp.float32)
    xr, xc = jnp.split(xf, 2, axis=-1)
    ar, ac = ang_r[:, None, None, :], ang_c[:, None, None, :]
    return jnp.concatenate([_rotate(xr, ar), _rotate(xc, ac)], axis=-1).astype(x.dtype)


def diff_attend(q, k, v, lam):
    s = jnp.einsum('bhqmd,bhkmd->bhmqk', q.astype(jnp.float32), k.astype(jnp.float32)) * (ATT_HEAD_DIM ** -0.5)
    p = jax.nn.softmax(s, axis=-1)
    w = p[:, :, 0] - lam * p[:, :, 1]
    return jnp.einsum('bhqk,bhkv->bhqv', w, v.astype(jnp.float32))


def diff_attention_latent(q, k, v, lam):
    b, h, n_tok = q.shape[:3]
    nb = n_tok // Q_BLOCK
    qb = q.reshape(b, h, nb, Q_BLOCK, 2, ATT_HEAD_DIM).transpose(2, 0, 1, 3, 4, 5)
    ob = lax.map(lambda blk: diff_attend(blk, k, v, lam), qb)
    return ob.transpose(1, 2, 0, 3, 4).reshape(b, h, n_tok, ATT_V_DIM)


def gla_chunk_scan(q, k, v, log_f, s0):
    b, h, n_tok, _ = q.shape
    dv = v.shape[-1]
    n_chunks = n_tok // CHUNK

    def chunks(a):
        return a.reshape(b, h, n_chunks, CHUNK, a.shape[-1]).transpose(2, 0, 1, 3, 4)

    lower = jnp.tril(jnp.ones((CHUNK, CHUNK), dtype=bool))[:, :, None]

    def step(state, inp):
        qc, kc, vc, gc = inp
        g_cum = jnp.cumsum(gc, axis=2)
        inter = jnp.einsum('bhtd,bhde->bhte', qc * jnp.exp(g_cum), state)
        rel = g_cum[:, :, :, None, :] - g_cum[:, :, None, :, :]
        decay = jnp.exp(jnp.where(lower, rel, -jnp.inf))
        scores = jnp.einsum('bhtd,bhsd,bhtsd->bhts', qc, kc, decay)
        intra = jnp.einsum('bhts,bhse->bhte', scores, vc)
        g_last = g_cum[:, :, -1:, :]
        new_state = (jnp.exp(g_last[:, :, 0, :, None]) * state
                     + jnp.einsum('bhsd,bhse->bhde', kc * jnp.exp(g_last - g_cum), vc))
        return new_state, inter + intra

    s_fin, out = lax.scan(step, s0, (chunks(q), chunks(k), chunks(v), chunks(log_f)))
    return out.transpose(1, 2, 0, 3, 4).reshape(b, h, n_tok, dv), s_fin


def hgrn2_forget(z, lb):
    log_f = jnp.logaddexp(jnp.log(lb), jnp.log1p(-lb) + jax.nn.log_sigmoid(z))
    k = (1.0 - lb) * jax.nn.sigmoid(-z)
    return k, log_f


def bidir_hgrn2(q, k_f, k_b, v, log_f_f, log_f_b, s0_f, s0_b):
    o_f, s_f = gla_chunk_scan(q, k_f, v, log_f_f, s0_f)
    o_b, s_b = gla_chunk_scan(jnp.flip(q, 2), jnp.flip(k_b, 2), jnp.flip(v, 2), jnp.flip(log_f_b, 2), s0_b)
    return o_f + jnp.flip(o_b, 2), s_f, s_b


def merge_branches(o_att, o_rec, rec_gate, gate_att, gate_rec, lam_init, g_subln, g_rec, w_br_a, w_br_r, w_out, dt):
    b, _, n_tok, _ = o_att.shape
    a = rmsnorm(o_att.transpose(0, 2, 1, 3), g_subln) * (1.0 - lam_init)
    a = a.reshape(b, n_tok, ATT_WIDTH).astype(dt)
    r = rmsnorm(o_rec.transpose(0, 2, 1, 3), g_rec).reshape(b, n_tok, REC_WIDTH)
    r = (r * jax.nn.silu(rec_gate.astype(jnp.float32))).astype(dt)
    mixed = jax.nn.sigmoid(gate_att) * (a @ w_br_a) + jax.nn.sigmoid(gate_rec) * (r @ w_br_r)
    return mixed @ w_out


def token_mixers(h, hc, w_in, lam, lam_init, g_subln, lb, g_rec, w_br_a, w_br_r, w_out, ang_r, ang_c, need_ctx):
    b, n_lat, _ = h.shape
    n_ctx = hc.shape[1]
    dt = h.dtype
    aq, ak, av, rq, rff, rfb, ri, rg, ga, gr = project(h, w_in)
    aqc, akc, avc, rqc, rffc, rfbc, ric, rgc, gac, grc = project(hc, w_in)

    def att_qk(a, n):
        return a.reshape(b, n, ATT_HEADS, 2, ATT_HEAD_DIM)

    def att_v(a, n):
        return a.reshape(b, n, ATT_HEADS, ATT_V_DIM).transpose(0, 2, 1, 3)

    q_l = axial_rope(att_qk(aq, n_lat), ang_r, ang_c).transpose(0, 2, 1, 3, 4)
    k_l = axial_rope(att_qk(ak, n_lat), ang_r, ang_c).transpose(0, 2, 1, 3, 4)
    q_c = att_qk(aqc, n_ctx).transpose(0, 2, 1, 3, 4)
    k_c = att_qk(akc, n_ctx).transpose(0, 2, 1, 3, 4)
    v_l, v_c = att_v(av, n_lat), att_v(avc, n_ctx)
    k_all = jnp.concatenate([k_c, k_l], axis=2)
    v_all = jnp.concatenate([v_c, v_l], axis=2)
    o_att = diff_attention_latent(q_l, k_all, v_all, lam)

    def rec(a, n, dim):
        return a.reshape(b, n, REC_HEADS, dim).transpose(0, 2, 1, 3).astype(jnp.float32)

    lb = lb.reshape(REC_HEADS, 1, REC_KEY_DIM)
    kcf, gcf = hgrn2_forget(rec(rffc, n_ctx, REC_KEY_DIM), lb)
    kcb, gcb = hgrn2_forget(rec(rfbc, n_ctx, REC_KEY_DIM), lb)
    s0 = jnp.zeros((b, REC_HEADS, REC_KEY_DIM, REC_VAL_DIM), jnp.float32)
    o_rec_c, s_f, s_b = bidir_hgrn2(rec(rqc, n_ctx, REC_KEY_DIM), kcf, kcb, rec(ric, n_ctx, REC_VAL_DIM), gcf, gcb, s0, s0)
    klf, glf = hgrn2_forget(rec(rff, n_lat, REC_KEY_DIM), lb)
    klb, glb = hgrn2_forget(rec(rfb, n_lat, REC_KEY_DIM), lb)
    o_rec, _, _ = bidir_hgrn2(rec(rq, n_lat, REC_KEY_DIM), klf, klb, rec(ri, n_lat, REC_VAL_DIM), glf, glb, s_f, s_b)

    y = merge_branches(o_att, o_rec, rg, ga, gr, lam_init, g_subln, g_rec, w_br_a, w_br_r, w_out, dt)
    yc = None
    if need_ctx:
        o_att_c = diff_attend(q_c, k_c, v_c, lam)
        yc = merge_branches(o_att_c, o_rec_c, rgc, gac, grc, lam_init, g_subln, g_rec, w_br_a, w_br_r, w_out, dt)
    return y, yc


def moe_ffn(h, w_router, b_router, w_gate, w_up, w_down):
    scores = jax.nn.sigmoid(h.astype(jnp.float32) @ w_router.astype(jnp.float32))
    biased = (scores + b_router.astype(jnp.float32)).reshape(-1, N_GROUPS, EXPERTS_PER_GROUP)
    group_score = jnp.sum(lax.top_k(biased, TOP_K)[0], axis=-1)
    group = jnp.argmax(group_score, axis=-1)
    in_group = jnp.einsum('tge,tg->te', biased, jax.nn.one_hot(group, N_GROUPS, dtype=jnp.float32))
    _, local = lax.top_k(in_group, TOP_K)
    expert = group[:, None] * EXPERTS_PER_GROUP + local
    w = jnp.take_along_axis(scores, expert, axis=1)
    w = w / jnp.sum(w, axis=-1, keepdims=True)
    gates = jnp.einsum('tk,tke->te', w, jax.nn.one_hot(expert, N_EXPERTS, dtype=jnp.float32))
    y = jnp.zeros(h.shape, jnp.float32)
    for e in range(N_EXPERTS):
        hid = jax.nn.silu(h @ w_gate[e]) * (h @ w_up[e])
        y = y + gates[:, e:e + 1] * (hid @ w_down[e]).astype(jnp.float32)
    return y.astype(h.dtype)


def setup_inputs(seed: int = 0) -> dict:
    key = jax.random.key(seed)
    ks = jax.random.split(key, 25)
    D = D_MODEL

    def nrm(k, shape, s):
        return jax.random.normal(k, shape, jnp.float32) * s

    return {
        'x': nrm(ks[0], (BATCH, SEQ, D), 1.0),
        'c': nrm(ks[1], (BATCH, D), 1.0),
        'ctx': nrm(ks[2], (BATCH, CTX_LEN, D), 1.0),
        'c_ctx': nrm(ks[3], (D,), 1.0),
        'w_mod': nrm(ks[4], (DEPTH, D, 6 * D), 0.5 * D ** -0.5),
        'b_mod': nrm(ks[5], (DEPTH, 6 * D), 0.01),
        'g_norm1': 1.0 + nrm(ks[6], (DEPTH, D), 0.02),
        'g_norm2': 1.0 + nrm(ks[7], (DEPTH, D), 0.02),
        'w_in': nrm(ks[8], (DEPTH, D, N_IN), D ** -0.5),
        'lambda_q1': nrm(ks[9], (DEPTH, ATT_HEAD_DIM), 0.1),
        'lambda_k1': nrm(ks[10], (DEPTH, ATT_HEAD_DIM), 0.1),
        'lambda_q2': nrm(ks[11], (DEPTH, ATT_HEAD_DIM), 0.1),
        'lambda_k2': nrm(ks[12], (DEPTH, ATT_HEAD_DIM), 0.1),
        'g_subln': 1.0 + nrm(ks[13], (DEPTH, ATT_V_DIM), 0.02),
        'lb_logits': nrm(ks[14], (DEPTH, REC_KEY_WIDTH), 0.5),
        'g_rec_norm': 1.0 + nrm(ks[15], (DEPTH, REC_VAL_DIM), 0.02),
        'w_br_attn': nrm(ks[16], (DEPTH, ATT_WIDTH, D), ATT_WIDTH ** -0.5),
        'w_br_rec': nrm(ks[17], (DEPTH, REC_WIDTH, D), REC_WIDTH ** -0.5),
        'w_out': nrm(ks[18], (DEPTH, D, D), D ** -0.5),
        'w_router': nrm(ks[19], (D, N_EXPERTS), D ** -0.5),
        'b_router': nrm(ks[20], (N_EXPERTS,), 0.01),
        'w_gate': nrm(ks[21], (DEPTH, N_EXPERTS, D, D_EXPERT), D ** -0.5),
        'w_up': nrm(ks[22], (DEPTH, N_EXPERTS, D, D_EXPERT), D ** -0.5),
        'w_down': nrm(ks[23], (DEPTH, N_EXPERTS, D_EXPERT, D), D_EXPERT ** -0.5),
        'g_final': 1.0 + nrm(ks[24], (D,), 0.02),
    }


def reference(x, c, ctx, c_ctx, w_mod, b_mod, g_norm1, g_norm2, w_in, lambda_q1, lambda_k1, lambda_q2, lambda_k2,
              g_subln, lb_logits, g_rec_norm, w_br_attn, w_br_rec, w_out, w_router, b_router, w_gate, w_up, w_down, g_final):
    b, n_lat, d = x.shape
    ang_r, ang_c = axial_angles(n_lat)
    lbs = jnp.cumsum(jax.nn.softmax(lb_logits.astype(jnp.float32), axis=0), axis=0)
    lbs = lbs - lbs[:1]
    xc = ctx
    for l in range(DEPTH):
        last = l == DEPTH - 1
        lam_init = 0.8 - 0.6 * math.exp(-0.3 * l)
        lam = (jnp.exp(jnp.sum(lambda_q1[l].astype(jnp.float32) * lambda_k1[l].astype(jnp.float32)))
               - jnp.exp(jnp.sum(lambda_q2[l].astype(jnp.float32) * lambda_k2[l].astype(jnp.float32))) + lam_init)
        mod = jax.nn.silu(c) @ w_mod[l] + b_mod[l]
        sh1, sc1, gt1, sh2, sc2, gt2 = [m[:, None, :] for m in jnp.split(mod, 6, axis=-1)]
        mod_c = jax.nn.silu(c_ctx) @ w_mod[l] + b_mod[l]
        sh1c, sc1c, gt1c, sh2c, sc2c, gt2c = jnp.split(mod_c, 6, axis=-1)

        h = modulate(rmsnorm(x, g_norm1[l]), sh1, sc1)
        hc = modulate(rmsnorm(xc, g_norm1[l]), sh1c, sc1c)
        y, yc = token_mixers(h, hc, w_in[l], lam, lam_init, g_subln[l], lbs[l], g_rec_norm[l],
                             w_br_attn[l], w_br_rec[l], w_out[l], ang_r, ang_c, not last)
        x = x + gt1 * y
        h2 = modulate(rmsnorm(x, g_norm2[l]), sh2, sc2)
        if not last:
            xc = xc + gt1c * yc
            h2c = modulate(rmsnorm(xc, g_norm2[l]), sh2c, sc2c)
            n_ctx_tok = b * xc.shape[1]
            tokens = jnp.concatenate([h2c.reshape(-1, d), h2.reshape(-1, d)], axis=0)
            out = moe_ffn(tokens, w_router, b_router, w_gate[l], w_up[l], w_down[l])
            xc = xc + gt2c * out[:n_ctx_tok].reshape(xc.shape)
            x = x + gt2 * out[n_ctx_tok:].reshape(x.shape)
        else:
            x = x + gt2 * moe_ffn(h2.reshape(-1, d), w_router, b_router, w_gate[l], w_up[l], w_down[l]).reshape(x.shape)
    return rmsnorm(x, g_final)
```

```cpp
#include <hip/hip_runtime.h>
#include <cstdio>
#include <cstdint>
namespace pg8 {
#define PG8_LAS __attribute__((address_space(3)))
typedef unsigned short bf16_t;
typedef short bf16x8 __attribute__((ext_vector_type(8)));
typedef float f32x4 __attribute__((ext_vector_type(4)));
typedef unsigned u32x4 __attribute__((ext_vector_type(4)));
constexpr int BM = 256, BK = 64, HALF = 128, HTB = HALF * BK * 2  , STAGE_BYTES = 8 * HTB, NXCD = 8, WGM = 8;

__host__ __device__ __forceinline__ int lds_byte(int r, int c) { const int st = (r >> 4) * 2 + (c >> 5), rr = r & 15, cc = c & 31, ob = rr * 64 + cc * 2; return st * 1024 + (ob ^ (((ob >> 9) & 1) << 5)); }
__host__ __device__ __forceinline__ void stage_rc(int b, int& R, int& C) { const int st = b / 1024, sb = b % 1024, swz = sb ^ (((sb >> 9) & 1) << 5); R = (st >> 1) * 16 + swz / 64; C = (st & 1) * 32 + (swz % 64) / 2; }
__host__ __device__ __forceinline__ int perm32(int rho) { const int n = rho >> 4, i = rho & 15; return 8 * (i >> 2) + 4 * n + (i & 3); }

struct Unit { int pm, pn; };
struct Gemm { const bf16_t* A; const bf16_t* Bt; int M, N, K; };
__device__ __forceinline__ unsigned cvt_pk_bf16(float lo, float hi) { unsigned r; asm volatile("v_cvt_pk_bf16_f32 %0, %1, %2" : "=v"(r) : "v"(lo), "v"(hi)); return r; }
template <class Epi, class Sched, bool ALIGN_EPI = false, bool SP2 = false>
__device__ __forceinline__ void gemm_phase(PG8_LAS unsigned char* lds, const Gemm g, const Sched& S, const Epi& E) {
    int tid_ = threadIdx.x; asm volatile("" : "+v"(tid_));
    const int tid = tid_, wid = __builtin_amdgcn_readfirstlane(tid >> 6), lane = tid & 63, wr = wid >> 2, wc = wid & 3, fr = lane & 15, fq = lane >> 4;
    const int K = g.K, nt = K / BK;
    unsigned voffA[2], voffB[2];
#pragma unroll
    for (int i = 0; i < 2; ++i) { int R, C; stage_rc(tid * 16 + i * 8192, R, C); const int Rb = Epi::PERM ? ((R & ~31) + perm32(R & 31)) : R;
        voffA[i] = (unsigned)(R * K + C) * 2u; voffB[i] = (unsigned)(Rb * K + C) * 2u; }
    const size_t kstep = (size_t)(BK * 2);
    const size_t hstep = (size_t)HALF * K * 2;
    const size_t tstep = 2 * hstep;
    const unsigned ldsw = (unsigned)wid * 1024u;
    const int aoff = lds_byte(wr * 64 + fr, fq * 8), boff = lds_byte(wc * 32 + fr, fq * 8);
#define PG8_SA(b, h) (((b) * 2 + (h)) * HTB)
#define PG8_SB(b, h) ((4 + (b) * 2 + (h)) * HTB)
#define PG8_STAGE(bufoff, gbase, voff) do { _Pragma("unroll") for (int _i = 0; _i < 2; ++_i) \
        __builtin_amdgcn_global_load_lds((const unsigned*)((const char*)(gbase) + (voff)[_i]), (PG8_LAS unsigned*)(lds + (bufoff) + ldsw + _i * 8192), 16, 0, 0); } while (0)
#define PG8_LDA(dst, b, h) do { _Pragma("unroll") for (int m = 0; m < 4; ++m) _Pragma("unroll") for (int k = 0; k < 2; ++k) dst[m][k] = *(const PG8_LAS bf16x8*)(lds + PG8_SA(b, h) + aoff + m * 2048 + k * 1024); } while (0)
#define PG8_LDB(dst, b, h) do { _Pragma("unroll") for (int n = 0; n < 2; ++n) _Pragma("unroll") for (int k = 0; k < 2; ++k) dst[n][k] = *(const PG8_LAS bf16x8*)(lds + PG8_SB(b, h) + boff + n * 2048 + k * 1024); } while (0)
#define PG8_MMA(ai, bj, At, Bt) do { __builtin_amdgcn_s_setprio(1); _Pragma("unroll") for (int m = 0; m < 4; ++m) _Pragma("unroll") for (int n = 0; n < 2; ++n) _Pragma("unroll") for (int k = 0; k < 2; ++k) \
        acc[ai][bj][m][n] = __builtin_amdgcn_mfma_f32_16x16x32_bf16(Bt[n][k], At[m][k], acc[ai][bj][m][n], 0, 0, 0); __builtin_amdgcn_s_setprio(0); } while (0)
#define PG8_WAIT_V(n) asm volatile("s_waitcnt vmcnt(" #n ")" ::: "memory")
#define PG8_WAIT_L(n) asm volatile("s_waitcnt lgkmcnt(" #n ")" ::: "memory")
#define PG8_BAR __builtin_amdgcn_s_barrier()
#define PG8_SCHED __builtin_amdgcn_sched_barrier(0)
    Unit cur, nxt; int ui = 0;
    if (!S.next(0, cur)) return;
    f32x4 acc[2][2][4][2];
#pragma unroll
    for (int a = 0; a < 2; ++a)
#pragma unroll
        for (int b = 0; b < 2; ++b)
#pragma unroll
            for (int m = 0; m < 4; ++m)
#pragma unroll
                for (int n = 0; n < 2; ++n) acc[a][b][m][n] = (f32x4){0.f, 0.f, 0.f, 0.f};
    bf16x8 At[4][2], B0[2][2], B1[2][2];
    const char* cA = (const char*)g.A + (size_t)cur.pm * tstep; const char* cB = (const char*)g.Bt + (size_t)cur.pn * tstep;
    S.a_ready(cur);
    if constexpr (SP2) {
        PG8_STAGE(PG8_SB(0, 0), cB, voffB); PG8_STAGE(PG8_SB(0, 1), cB + hstep, voffB); PG8_STAGE(PG8_SA(0, 0), cA, voffA); PG8_STAGE(PG8_SA(0, 1), cA + hstep, voffA);
        if (wr == 1) PG8_BAR;
        PG8_WAIT_V(2); PG8_BAR;
        PG8_STAGE(PG8_SB(1, 0), cB + kstep, voffB); PG8_STAGE(PG8_SA(1, 0), cA + kstep, voffA); PG8_STAGE(PG8_SB(1, 1), cB + hstep + kstep, voffB);
        PG8_WAIT_V(6); PG8_BAR;
    } else {
        PG8_STAGE(PG8_SB(0, 0), cB, voffB); PG8_STAGE(PG8_SA(0, 0), cA, voffA); PG8_STAGE(PG8_SB(0, 1), cB + hstep, voffB); PG8_STAGE(PG8_SA(0, 1), cA + hstep, voffA);
        if (wr == 1) PG8_BAR;
        PG8_WAIT_V(4); PG8_BAR;
        PG8_STAGE(PG8_SB(1, 0), cB + kstep, voffB); PG8_STAGE(PG8_SA(1, 0), cA + kstep, voffA); PG8_STAGE(PG8_SB(1, 1), cB + hstep + kstep, voffB);
        PG8_WAIT_V(6); PG8_BAR;
    }
    for (;;) {
        const bool has_next = S.next(ui + 1, nxt);
        const char* nA = has_next ? (const char*)g.A + (size_t)nxt.pm * tstep : cA; const char* nB = has_next ? (const char*)g.Bt + (size_t)nxt.pn * tstep : cB;
        for (int t = 0; t < nt; t += 2) {
            if constexpr (Epi::HAS_MID) { if (t == (nt >> 1)) E.mid(acc, cur, wr, wc, fr, fq); }
            const bool last = (t == nt - 2);
            const char* a1 = cA + (size_t)(t + 1) * kstep;
            const char* a2 = last ? nA : cA + (size_t)(t + 2) * kstep; const char* b2 = last ? nB : cB + (size_t)(t + 2) * kstep;
            const char* a3 = a2 + kstep; const char* b3 = b2 + kstep;
            if (last && has_next) S.a_ready(nxt);
            if constexpr (SP2) {
            PG8_LDB(B0, 0, 0); PG8_LDB(B1, 0, 1); PG8_SCHED; PG8_LDA(At, 0, 0); PG8_STAGE(PG8_SA(1, 1), a1 + hstep, voffA);
            PG8_WAIT_V(8); PG8_WAIT_L(0); PG8_BAR; PG8_MMA(0, 0, At, B0); PG8_MMA(0, 1, At, B1); PG8_BAR; PG8_SCHED;
            PG8_LDA(At, 0, 1); PG8_STAGE(PG8_SB(0, 0), b2, voffB); PG8_STAGE(PG8_SB(0, 1), b2 + hstep, voffB); PG8_STAGE(PG8_SA(0, 0), a2, voffA);
            PG8_WAIT_V(8); PG8_WAIT_L(0); PG8_BAR; PG8_MMA(1, 0, At, B0); PG8_MMA(1, 1, At, B1); PG8_BAR; PG8_SCHED;
            PG8_LDB(B0, 1, 0); PG8_LDB(B1, 1, 1); PG8_SCHED; PG8_LDA(At, 1, 0); PG8_STAGE(PG8_SA(0, 1), a2 + hstep, voffA);
            PG8_WAIT_V(8); PG8_WAIT_L(0); PG8_BAR; PG8_MMA(0, 0, At, B0); PG8_MMA(0, 1, At, B1); PG8_BAR; PG8_SCHED;
            PG8_LDA(At, 1, 1); PG8_STAGE(PG8_SB(1, 0), b3, voffB); PG8_STAGE(PG8_SB(1, 1), b3 + hstep, voffB); PG8_STAGE(PG8_SA(1, 0), a3, voffA);
            PG8_WAIT_V(8); PG8_WAIT_L(0); PG8_BAR; PG8_MMA(1, 0, At, B0); PG8_MMA(1, 1, At, B1); PG8_BAR; PG8_SCHED;
            } else {
            PG8_LDB(B0, 0, 0); PG8_SCHED; PG8_LDA(At, 0, 0); PG8_STAGE(PG8_SA(1, 1), a1 + hstep, voffA);
            PG8_WAIT_L(8); PG8_BAR; PG8_WAIT_L(0); PG8_MMA(0, 0, At, B0); PG8_BAR; PG8_SCHED;
            PG8_LDB(B1, 0, 1); PG8_STAGE(PG8_SB(0, 0), b2, voffB);
            PG8_BAR; PG8_WAIT_L(0); PG8_MMA(0, 1, At, B1); PG8_BAR;
            PG8_LDA(At, 0, 1); PG8_STAGE(PG8_SA(0, 0), a2, voffA);
            PG8_BAR; PG8_WAIT_L(0); PG8_MMA(1, 0, At, B0); PG8_BAR; PG8_SCHED;
            PG8_STAGE(PG8_SB(0, 1), b2 + hstep, voffB);
            PG8_WAIT_V(6); PG8_BAR; PG8_MMA(1, 1, At, B1); PG8_BAR;
            PG8_LDB(B0, 1, 0); PG8_SCHED; PG8_LDA(At, 1, 0); PG8_STAGE(PG8_SA(0, 1), a2 + hstep, voffA);
            PG8_WAIT_L(8); PG8_BAR; PG8_WAIT_L(0); PG8_MMA(0, 0, At, B0); PG8_BAR; PG8_SCHED;
            PG8_LDB(B1, 1, 1); PG8_STAGE(PG8_SB(1, 0), b3, voffB);
            PG8_BAR; PG8_WAIT_L(0); PG8_MMA(0, 1, At, B1); PG8_BAR;
            PG8_LDA(At, 1, 1); PG8_STAGE(PG8_SA(1, 0), a3, voffA);
            PG8_BAR; PG8_WAIT_L(0); PG8_MMA(1, 0, At, B0); PG8_BAR; PG8_SCHED;
            PG8_STAGE(PG8_SB(1, 1), b3 + hstep, voffB);
            PG8_WAIT_V(6); PG8_BAR; PG8_MMA(1, 1, At, B1); PG8_BAR;
            }
        }
        if constexpr (ALIGN_EPI) { if (wr == 0) PG8_BAR; }
        if constexpr (!Epi::AFTER_DRAIN) { E(acc, cur, wr, wc, fr, fq); S.done(cur); }
        if (!has_next) break;
#pragma unroll
        for (int a = 0; a < 2; ++a)
#pragma unroll
            for (int b = 0; b < 2; ++b)
#pragma unroll
                for (int m = 0; m < 4; ++m)
#pragma unroll
                    for (int n = 0; n < 2; ++n) acc[a][b][m][n] = (f32x4){0.f, 0.f, 0.f, 0.f};
        cur = nxt; cA = nA; cB = nB; ++ui;
        if constexpr (ALIGN_EPI) { if (wr == 1) PG8_BAR; }
    }
    PG8_WAIT_V(0);
    if constexpr (!ALIGN_EPI) { if (wr == 0) PG8_BAR; }
    PG8_BAR;
    if constexpr (Epi::AFTER_DRAIN) { E.fused(acc, cur, wr, wc, fr, fq, lds, wid, lane); S.done(cur); }
#undef PG8_SA
#undef PG8_SB
#undef PG8_STAGE
#undef PG8_LDA
#undef PG8_LDB
#undef PG8_MMA
#undef PG8_WAIT_V
#undef PG8_WAIT_L
#undef PG8_BAR
#undef PG8_SCHED
}
}
#define GAS __attribute__((address_space(1)))
#define LAS __attribute__((address_space(3)))
#define XB_TMO      128
#define XB_XCNT(j)  (256  + 64 * (j))
#define XB_XSUB(j)  (1280 + 64 * (j))
#define XB_XGEN(j)  (2304 + 64 * (j))
#define XB_TOP      3328
#define XB_TOPGEN   3392
#define XCD_BAR_WORDS 3456
#define XB_SPIN_CAP (1u << 18)

__device__ __forceinline__ unsigned xb_ld(unsigned* p)              { return __hip_atomic_load(p, __ATOMIC_RELAXED, __HIP_MEMORY_SCOPE_AGENT); }
__device__ __forceinline__ unsigned xb_add(unsigned* p, unsigned v) { return __hip_atomic_fetch_add(p, v, __ATOMIC_RELAXED, __HIP_MEMORY_SCOPE_AGENT); }
__device__ __forceinline__ unsigned xb_xcc_id() { return (unsigned)__builtin_amdgcn_s_getreg((3 << 11) | 20) & 0xFu; }
#define XB_SPIN(cond, bar) do { unsigned _sp = 0; while (cond) { __builtin_amdgcn_s_sleep(1); \
    if ((++_sp & 255u) == 0u) { if (xb_ld(&(bar)[XB_TMO])) break; if (_sp > XB_SPIN_CAP) { atomicAdd(&(bar)[XB_TMO], 1u); break; } } } } while (0)

struct XcdBarrier {
    unsigned* bar; unsigned x;
    volatile LAS unsigned* st;
};

__device__ __forceinline__ XcdBarrier xcd_barrier_post(unsigned* bar, volatile LAS unsigned* st) {
    XcdBarrier b; b.bar = bar; b.x = xb_xcc_id(); b.st = st;
    if (threadIdx.x == 0) (void)xb_add(&bar[XB_XCNT(b.x)], 1u);
    return b;
}
__device__ __forceinline__ void xcd_barrier_complete(unsigned* bar, unsigned x, unsigned& nloc, unsigned& nx) {
    const unsigned G = gridDim.x * gridDim.y * gridDim.z;
    unsigned sum, cnt, mine, sp = 0u;
    for (;;) {
        sum = 0u; cnt = 0u; mine = 0u;
#pragma unroll
        for (unsigned j = 0; j < 16; ++j) { const unsigned c = xb_ld(&bar[XB_XCNT(j)]); sum += c; cnt += (c > 0u) ? 1u : 0u; mine = (j == x) ? c : mine; }
        if (sum == G) break;
        __builtin_amdgcn_s_sleep(1);
        if ((++sp & 255u) == 0u) { if (xb_ld(&bar[XB_TMO])) break; if (sp > XB_SPIN_CAP) { atomicAdd(&bar[XB_TMO], 1u); break; } }
    }
    nloc = mine > 0u ? mine : 1u; nx = cnt > 0u ? cnt : 1u;
}

__device__ __forceinline__ void xcd_barrier(const XcdBarrier& b) {
    asm volatile("s_waitcnt vmcnt(0)" ::: "memory");
    __syncthreads();
    if (threadIdx.x == 0) {
        unsigned* bar = b.bar;
        __builtin_amdgcn_s_waitcnt(0);
        unsigned nloc = b.st[0], nx = b.st[1];
        if (nloc == 0u) { xcd_barrier_complete(bar, b.x, nloc, nx); b.st[0] = nloc; b.st[1] = nx; }
        const unsigned old = xb_add(&bar[XB_XSUB(b.x)], 1u);
        const unsigned gen = old / nloc;
        if (old + 1u == (gen + 1u) * nloc) {
            __builtin_amdgcn_fence(__ATOMIC_RELEASE, "agent");
            asm volatile("s_waitcnt vmcnt(0)" ::: "memory");
            const unsigned og = xb_add(&bar[XB_TOP], 1u);
            const unsigned tg = og / nx;
            if (og + 1u == (tg + 1u) * nx) xb_add(&bar[XB_TOPGEN], 1u);
            else XB_SPIN(xb_ld(&bar[XB_TOPGEN]) == tg, bar);
            __builtin_amdgcn_fence(__ATOMIC_ACQUIRE, "agent");
            xb_add(&bar[XB_XGEN(b.x)], 1u);
            asm volatile("s_waitcnt vmcnt(0)" ::: "memory");
        } else {
            XB_SPIN(xb_ld(&bar[XB_XGEN(b.x)]) == gen, bar);
            __builtin_amdgcn_fence(__ATOMIC_ACQUIRE, "agent");
            asm volatile("s_waitcnt vmcnt(0)" ::: "memory");
        }
    }
    __syncthreads();
}

typedef unsigned short bf16;
typedef unsigned v4u __attribute__((ext_vector_type(4)));
typedef unsigned v2u __attribute__((ext_vector_type(2)));
typedef float f32x4 __attribute__((ext_vector_type(4)));
typedef float f32x2 __attribute__((ext_vector_type(2)));
typedef float f32x16 __attribute__((ext_vector_type(16)));
typedef short bf16x8 __attribute__((ext_vector_type(8)));
typedef short s16x4 __attribute__((ext_vector_type(4)));

constexpr int D = 1024, NBATCH = 16, SEQ = 2048, CTXL = 256, TPB = CTXL + SEQ, NLAYER = 2;
constexpr int NBG = 8, NGRP = NBATCH / NBG, GT = NBG * TPB, GTILES = GT / 256;
constexpr int NIN = 10240, NEXP = 16, NWAVES = 8, NTHREADS = NWAVES * 64;
constexpr float EPS = 1e-6f;
constexpr float QSCALE = 0.125f * 1.4426950408889634f;
constexpr size_t MiB = 1u << 20;
constexpr size_t WS_CTL = 0, CTL_ZERO_BYTES = 1 * MiB;
constexpr size_t WS_MOD = 1 * MiB;
constexpr size_t WS_ROPE = 2 * MiB;
constexpr size_t WS_MISC = 2 * MiB + 512 * 1024;
constexpr size_t WS_ROUTE = 3 * MiB;
constexpr size_t WS_XC = 4 * MiB;
constexpr size_t WS_WIN = 20 * MiB;
constexpr size_t WS_WAR = 40 * MiB;
constexpr size_t WS_WO = 44 * MiB;
constexpr size_t WS_WUP = 46 * MiB;
constexpr size_t WS_WDN = 110 * MiB;
constexpr size_t WS_PROJ = 142 * MiB;
constexpr size_t SEG_ELEMS = (size_t)GT * 1024;
constexpr size_t WS_AR = 502 * MiB;
constexpr size_t WS_OB = 574 * MiB;
constexpr size_t WS_END = 610 * MiB;
constexpr int MAXSLOT = 2 * GT + NEXP * 256;
constexpr size_t WS_H2S = 142 * MiB, WS_HID = 222 * MiB, WS_YE = 302 * MiB;
constexpr size_t WS_MIX = WS_PROJ;
static_assert(WS_YE + (size_t)MAXSLOT * 2048 <= WS_AR && WS_PROJ + 10 * SEG_ELEMS * 2 <= WS_AR && WS_AR + (size_t)GT * 4096 <= WS_OB && WS_OB + SEG_ELEMS * 2 <= WS_END, "ws map");
constexpr int RT_E = 0, RT_P = GT * 8, RT_W = 2 * GT * 8, RT_S = 3 * GT * 8;
constexpr int CW_BAR = 4096;
constexpr int CW_QUEUE = 16384;
constexpr int CW_CNT = 20480;
constexpr int RING_BYTES = 131072, LDSCTL_OFF = RING_BYTES, MISC_OFF = LDSCTL_OFF + 320, LDS_BYTES = 147456;

#define RLX_AGENT __ATOMIC_RELAXED, __HIP_MEMORY_SCOPE_AGENT
__device__ __forceinline__ unsigned f2bf(float f) { unsigned u = __builtin_bit_cast(unsigned, f); return (u + 0x7fffu + ((u >> 16) & 1u)) >> 16; }
__device__ __forceinline__ unsigned pk2(float lo, float hi) { return f2bf(lo) | (f2bf(hi) << 16); }
__device__ __forceinline__ float bf2f(unsigned short b) { return __builtin_bit_cast(float, (unsigned)b << 16); }
__device__ __forceinline__ float bflo(unsigned w) { return __builtin_bit_cast(float, w << 16); }
__device__ __forceinline__ float bfhi(unsigned w) { return __builtin_bit_cast(float, w & 0xffff0000u); }
__device__ __forceinline__ float sigmoidf_(float z) { return __builtin_amdgcn_rcpf(1.0f + __expf(-z)); }
__device__ __forceinline__ float wave_sum(float v) {
#pragma unroll
    for (int o = 1; o < 64; o <<= 1) v += __shfl_xor(v, o);
    return v;
}

__device__ __forceinline__ int ldg_i(const int* p) { return (int)__hip_atomic_load((const unsigned*)p, RLX_AGENT); }
__device__ __forceinline__ float ldg_f(const float* p) { return __builtin_bit_cast(float, __hip_atomic_load((const unsigned*)p, RLX_AGENT)); }

struct Args { const float* in[25]; float* out; unsigned char* ws; int ph_lo, ph_hi; };

struct DenseOrder {
    int mode, nM, nN, nwg, G, c, extra;
    __device__ void init(int mode_, int nN_, int G_, int c_) { mode = mode_; nM = (mode == 0) ? GTILES : NBG * 8; nN = nN_; nwg = nM * nN; G = G_; c = c_; extra = (mode == 2) ? NBG * 20 : 0; }
    __device__ bool next(int i, pg8::Unit& u) const {
        const int L = i * G + c; if (L >= nwg + extra) return false;
        if (L >= nwg) { const int r = L - nwg, bi = r / 20, ci = r % 20, sg = ci >> 2; u.pm = bi * 9; u.pn = ((sg == 0) ? 1 : (sg == 1) ? 2 : (sg + 2)) * 4 + (ci & 3); return true; }
        int wgid = L; { const int q = nwg / 8, r = nwg % 8, xcd = wgid % 8, off = wgid / 8; wgid = (xcd < r ? xcd * (q + 1) : r * (q + 1) + (xcd - r) * q) + off; }
        const int nig = 8 * nN, gid = wgid / nig, fm = gid * 8, gsz = (nM - fm) < 8 ? (nM - fm) : 8;
        const int pml = fm + ((wgid % nig) % gsz); u.pn = (wgid % nig) / gsz;
        u.pm = (mode == 0) ? pml : (pml >> 3) * 9 + 1 + (pml & 7);
        return true;
    }
    __device__ __forceinline__ void a_ready(const pg8::Unit&) const {}
    __device__ __forceinline__ void done(const pg8::Unit&) const {}
};
template <int NPN> struct MoeOrder {
    const int* tile_e; int nunits, G, c;
    __device__ void init(const int* te, int nt, int G_, int c_) { tile_e = te; nunits = nt * NPN; G = G_; c = c_; }
    __device__ bool next(int i, pg8::Unit& u) const {
        const int L = i * G + c; if (L >= nunits) return false;
        const int tm = L / NPN, pl = L % NPN; u.pm = tm; u.pn = __builtin_amdgcn_readfirstlane((int)__hip_atomic_load((const unsigned*)tile_e + tm, RLX_AGENT)) * NPN + pl; return true;
    }
    __device__ __forceinline__ void a_ready(const pg8::Unit&) const {}
    __device__ __forceinline__ void done(const pg8::Unit&) const {}
};

struct EpiInProj {
    static constexpr bool PERM = false, AFTER_DRAIN = false, HAS_MID = false;
    bf16* proj; const float* ropec; const float* ropes; const float* lb;
    __device__ __forceinline__ void operator()(const pg8::f32x4 (&acc)[2][2][4][2], const pg8::Unit& u, int wr, int wc, int fr_, int fq_) const {
        int fr = fr_, fq = fq_; asm volatile("" : "+v"(fr), "+v"(fq));
        const int seg = u.pn >> 2, tb = u.pm % 9; const bool lat = tb != 0;
        bf16* base = proj + (size_t)seg * SEG_ELEMS;
        const int colb = (u.pn & 3) * 256 + wc * 32 + 4 * fq;
#pragma unroll
        for (int ai = 0; ai < 2; ++ai)
#pragma unroll
            for (int m = 0; m < 4; ++m) {
                const int rl = ai * 128 + wr * 64 + m * 16 + fr; const size_t row = (size_t)u.pm * 256 + rl;
                f32x4 cs = {1.f, 1.f, 1.f, 1.f}, sn = {0.f, 0.f, 0.f, 0.f};
                if (seg < 2 && lat) { const int t = (tb - 1) * 256 + rl; cs = *(const f32x4*)(ropec + t * 32 + (wc & 1) * 16 + 4 * fq); sn = *(const f32x4*)(ropes + t * 32 + (wc & 1) * 16 + 4 * fq); }
#pragma unroll
                for (int bj = 0; bj < 2; ++bj) {
                    f32x4 v0 = acc[ai][bj][m][0], v1 = acc[ai][bj][m][1];
                    if (seg < 2) {
                        const f32x4 a = v0 * cs - v1 * sn, b = v0 * sn + v1 * cs; v0 = a; v1 = b;
                        if (seg == 0) { v0 = v0 * QSCALE; v1 = v1 * QSCALE; }
                    } else if (seg == 4 || seg == 5) {
                        const f32x4 l0 = *(const f32x4*)(lb + colb + bj * 128), l1 = *(const f32x4*)(lb + colb + bj * 128 + 16);
#pragma unroll
                        for (int j = 0; j < 4; ++j) {
                            { const float z = v0[j], lbv = l0[j]; const float g0 = fminf(z, 0.f) - __logf(1.0f + __expf(-fabsf(z))); const float g1 = __logf(lbv + (1.0f - lbv) * sigmoidf_(z)); v0[j] = (lbv == 0.f) ? g0 : g1; }
                            { const float z = v1[j], lbv = l1[j]; const float g0 = fminf(z, 0.f) - __logf(1.0f + __expf(-fabsf(z))); const float g1 = __logf(lbv + (1.0f - lbv) * sigmoidf_(z)); v1[j] = (lbv == 0.f) ? g0 : g1; }
                        }
                    } else if (seg == 7) {
#pragma unroll
                        for (int j = 0; j < 4; ++j) { v0[j] = v0[j] * sigmoidf_(v0[j]); v1[j] = v1[j] * sigmoidf_(v1[j]); }
                    } else if (seg >= 8) {
#pragma unroll
                        for (int j = 0; j < 4; ++j) { v0[j] = sigmoidf_(v0[j]); v1[j] = sigmoidf_(v1[j]); }
                    }
                    bf16* p = base + row * 1024 + colb + bj * 128;
                    v2u w0, w1; w0.x = pk2(v0[0], v0[1]); w0.y = pk2(v0[2], v0[3]); w1.x = pk2(v1[0], v1[1]); w1.y = pk2(v1[2], v1[3]);
                    *(v2u*)p = w0; *(v2u*)(p + 16) = w1;
                }
                asm volatile("" ::: "memory");
            }
    }
};
struct EpiMix {
    static constexpr bool PERM = true, AFTER_DRAIN = false, HAS_MID = true;
    const bf16* ga; const bf16* gr; bf16* mix;
    __device__ __forceinline__ void mid(pg8::f32x4 (&acc)[2][2][4][2], const pg8::Unit& u, int wr, int wc, int fr_, int fq_) const {
        int fr = fr_, fq = fq_; asm volatile("" : "+v"(fr), "+v"(fq));
        const int colb = u.pn * 256 + wc * 32 + 8 * fq;
#pragma unroll
        for (int ai = 0; ai < 2; ++ai)
#pragma unroll
            for (int m = 0; m < 4; ++m) { const size_t row = (size_t)u.pm * 256 + ai * 128 + wr * 64 + m * 16 + fr;
#pragma unroll
                for (int bj = 0; bj < 2; ++bj) { const v4u a = *(const v4u*)(ga + row * 1024 + colb + bj * 128), r = *(const v4u*)(gr + row * 1024 + colb + bj * 128);
                    f32x4 q0, q1;
                    q0[0] = bflo(a.x) * __builtin_amdgcn_rcpf(bflo(r.x)); q0[1] = bfhi(a.x) * __builtin_amdgcn_rcpf(bfhi(r.x)); q0[2] = bflo(a.y) * __builtin_amdgcn_rcpf(bflo(r.y)); q0[3] = bfhi(a.y) * __builtin_amdgcn_rcpf(bfhi(r.y));
                    q1[0] = bflo(a.z) * __builtin_amdgcn_rcpf(bflo(r.z)); q1[1] = bfhi(a.z) * __builtin_amdgcn_rcpf(bfhi(r.z)); q1[2] = bflo(a.w) * __builtin_amdgcn_rcpf(bflo(r.w)); q1[3] = bfhi(a.w) * __builtin_amdgcn_rcpf(bfhi(r.w));
                    acc[ai][bj][m][0] = acc[ai][bj][m][0] * q0; acc[ai][bj][m][1] = acc[ai][bj][m][1] * q1; } asm volatile("" ::: "memory"); }
    }
    __device__ __forceinline__ void operator()(const pg8::f32x4 (&acc)[2][2][4][2], const pg8::Unit& u, int wr, int wc, int fr_, int fq_) const {
        int fr = fr_, fq = fq_; asm volatile("" : "+v"(fr), "+v"(fq));
        const int colb = u.pn * 256 + wc * 32 + 8 * fq;
#pragma unroll
        for (int ai = 0; ai < 2; ++ai)
#pragma unroll
            for (int m = 0; m < 4; ++m) { const size_t row = (size_t)u.pm * 256 + ai * 128 + wr * 64 + m * 16 + fr;
#pragma unroll
                for (int bj = 0; bj < 2; ++bj) { const v4u r = *(const v4u*)(gr + row * 1024 + colb + bj * 128);
                    const f32x4 v0 = acc[ai][bj][m][0], v1 = acc[ai][bj][m][1]; v4u w;
                    w.x = pk2(v0[0] * bflo(r.x), v0[1] * bfhi(r.x)); w.y = pk2(v0[2] * bflo(r.y), v0[3] * bfhi(r.y));
                    w.z = pk2(v1[0] * bflo(r.z), v1[1] * bfhi(r.z)); w.w = pk2(v1[2] * bflo(r.w), v1[3] * bfhi(r.w));
                    *(v4u*)(mix + row * 1024 + colb + bj * 128) = w; } asm volatile("" ::: "memory"); }
    }
};
struct EpiOut {
    static constexpr bool PERM = false, AFTER_DRAIN = false, HAS_MID = false;
    const float* xsrc; float* xdst; const float* csrc; float* cdst; const float* mod; int bg0;
    __device__ __forceinline__ void operator()(const pg8::f32x4 (&acc)[2][2][4][2], const pg8::Unit& u, int wr, int wc, int fr_, int fq_) const {
        int fr = fr_, fq = fq_; asm volatile("" : "+v"(fr), "+v"(fq));
        const int bl = u.pm / 9, tb = u.pm % 9, bgl = bg0 + bl; const bool lat = tb != 0;
        const float* gate = mod + (size_t)(lat ? bgl : 16) * 6144 + 2 * 1024;
        const int colb = u.pn * 256 + wc * 32 + 4 * fq;
#pragma unroll
        for (int ai = 0; ai < 2; ++ai)
#pragma unroll
            for (int m = 0; m < 4; ++m) { const int rl = ai * 128 + wr * 64 + m * 16 + fr;
                const size_t xr = lat ? ((size_t)bgl * SEQ + (tb - 1) * 256 + rl) : ((size_t)bgl * CTXL + rl);
                const float* s = (lat ? xsrc : csrc) + xr * 1024; float* d = (lat ? xdst : cdst) + xr * 1024;
#pragma unroll
                for (int bj = 0; bj < 2; ++bj)
#pragma unroll
                    for (int n = 0; n < 2; ++n) { const int c = colb + bj * 128 + n * 16; const f32x4 g = *(const f32x4*)(gate + c), x = *(const f32x4*)(s + c);
                        *(f32x4*)(d + c) = x + g * acc[ai][bj][m][n]; } asm volatile("" ::: "memory"); }
    }
};
struct EpiUp {
    static constexpr bool PERM = false, AFTER_DRAIN = false, HAS_MID = false;
    bf16* hid;
    __device__ __forceinline__ void operator()(const pg8::f32x4 (&acc)[2][2][4][2], const pg8::Unit& u, int wr, int wc, int fr_, int fq_) const {
        int fr = fr_, fq = fq_; asm volatile("" : "+v"(fr), "+v"(fq));
        const int jb = (u.pn & 7) * 128 + wc * 16 + 4 * fq;
#pragma unroll
        for (int ai = 0; ai < 2; ++ai)
#pragma unroll
            for (int m = 0; m < 4; ++m) { const size_t row = (size_t)u.pm * 256 + ai * 128 + wr * 64 + m * 16 + fr;
#pragma unroll
                for (int bj = 0; bj < 2; ++bj) { const f32x4 g = acc[ai][bj][m][0], up = acc[ai][bj][m][1]; f32x4 h;
#pragma unroll
                    for (int j = 0; j < 4; ++j) h[j] = g[j] * sigmoidf_(g[j]) * up[j];
                    v2u w; w.x = pk2(h[0], h[1]); w.y = pk2(h[2], h[3]); *(v2u*)(hid + row * 1024 + jb + bj * 64) = w; } asm volatile("" ::: "memory"); }
    }
};
struct EpiDown {
    static constexpr bool PERM = true, AFTER_DRAIN = false, HAS_MID = false;
    bf16* ye;
    __device__ __forceinline__ void operator()(const pg8::f32x4 (&acc)[2][2][4][2], const pg8::Unit& u, int wr, int wc, int fr_, int fq_) const {
        int fr = fr_, fq = fq_; asm volatile("" : "+v"(fr), "+v"(fq));
        const int colb = (u.pn & 3) * 256 + wc * 32 + 8 * fq;
#pragma unroll
        for (int ai = 0; ai < 2; ++ai)
#pragma unroll
            for (int m = 0; m < 4; ++m) { const size_t row = (size_t)u.pm * 256 + ai * 128 + wr * 64 + m * 16 + fr;
#pragma unroll
                for (int bj = 0; bj < 2; ++bj) { const f32x4 v0 = acc[ai][bj][m][0], v1 = acc[ai][bj][m][1]; v4u w;
                    w.x = pk2(v0[0], v0[1]); w.y = pk2(v0[2], v0[3]); w.z = pk2(v1[0], v1[1]); w.w = pk2(v1[2], v1[3]);
                    *(v4u*)(ye + row * 1024 + colb + bj * 128) = w; } asm volatile("" ::: "memory"); }
    }
};

template <int RMAP> __device__ __forceinline__ void transpose_item(const float* W, int N, bf16* WT, int ldk, int koff, LAS float* scr, int item, int lane) {
    const int nblk = N / 32, kb = item / nblk, nb = item % nblk, k0 = 64 * kb, n0 = 32 * nb;
#pragma unroll 8
    for (int i = 0; i < 32; ++i) { const int kk = 2 * i + (lane >> 5); scr[kk * 33 + (lane & 31)] = W[(size_t)(k0 + kk) * N + n0 + (lane & 31)]; }
    asm volatile("s_waitcnt lgkmcnt(0)" ::: "memory");
    const int c = lane & 7;
#pragma unroll
    for (int j = 0; j < 4; ++j) { const int nl = (lane >> 3) + 8 * j; const LAS float* s = scr + (8 * c) * 33 + nl; const int n = n0 + nl;
        const int row = (RMAP == 0) ? n : ((n >> 4) * 32 + (n & 15) + (RMAP == 2 ? 16 : 0));
        v4u o; o.x = pk2(s[0 * 33], s[1 * 33]); o.y = pk2(s[2 * 33], s[3 * 33]); o.z = pk2(s[4 * 33], s[5 * 33]); o.w = pk2(s[6 * 33], s[7 * 33]);
        *(v4u*)(WT + (size_t)row * ldk + koff + k0 + 8 * c) = o; }
    asm volatile("s_waitcnt lgkmcnt(0)" ::: "memory");
}
__device__ __forceinline__ void phase_weights(const Args& a, int l, LAS unsigned char* lds, int gw, int ngw, int wave, int lane) {
    LAS float* scr = (LAS float*)(lds + wave * 16384);
    unsigned char* ws = a.ws;
    constexpr int I_IN = 16 * (NIN / 32), I_SQ = 16 * 32;
    constexpr int NITEMS = I_IN + 3 * I_SQ + NEXP * 3 * I_SQ;
    for (int it = gw; it < NITEMS; it += ngw) {
        int r = it;
        if (r < I_IN) { transpose_item<0>(a.in[8] + (size_t)l * 1024 * NIN, NIN, (bf16*)(ws + WS_WIN), 1024, 0, scr, r, lane); continue; } r -= I_IN;
        if (r < I_SQ) { transpose_item<0>(a.in[16] + (size_t)l * 1048576, 1024, (bf16*)(ws + WS_WAR), 2048, 0, scr, r, lane); continue; } r -= I_SQ;
        if (r < I_SQ) { transpose_item<0>(a.in[17] + (size_t)l * 1048576, 1024, (bf16*)(ws + WS_WAR), 2048, 1024, scr, r, lane); continue; } r -= I_SQ;
        if (r < I_SQ) { transpose_item<0>(a.in[18] + (size_t)l * 1048576, 1024, (bf16*)(ws + WS_WO), 1024, 0, scr, r, lane); continue; } r -= I_SQ;
        const int e = r / (3 * I_SQ), w = (r / I_SQ) % 3, ii = r % I_SQ; const size_t eo = ((size_t)l * NEXP + e) * 1048576;
        if (w == 0) transpose_item<1>(a.in[21] + eo, 1024, (bf16*)(ws + WS_WUP) + (size_t)e * 2048 * 1024, 1024, 0, scr, ii, lane);
        else if (w == 1) transpose_item<2>(a.in[22] + eo, 1024, (bf16*)(ws + WS_WUP) + (size_t)e * 2048 * 1024, 1024, 0, scr, ii, lane);
        else transpose_item<0>(a.in[23] + eo, 1024, (bf16*)(ws + WS_WDN) + (size_t)e * 1024 * 1024, 1024, 0, scr, ii, lane);
    }
}
__device__ __forceinline__ void phase_prologue(const Args& a, LAS unsigned char* lds, int tid, int G) {
    unsigned char* ws = a.ws; float* MOD = (float*)(ws + WS_MOD);
    LAS float* sc = (LAS float*)lds;
    LAS float* red = (LAS float*)(lds + 1024 * 20 * 4);
    for (int i = tid; i < 17 * 1024; i += NTHREADS) { const int bi = i >> 10, k = i & 1023; const float v = (bi < 16) ? a.in[1][bi * 1024 + k] : a.in[3][k]; sc[k * 20 + bi] = v * sigmoidf_(v); }
    __syncthreads();
    const int j = tid & 63, ks = tid >> 6;
    for (int u = blockIdx.x; u < 2 * 96; u += G) {
        const int l = u / 96, col0 = (u % 96) * 64; const float* wm = a.in[4] + (size_t)l * 1024 * 6144 + col0 + j;
        float acc[17];
#pragma unroll
        for (int b = 0; b < 17; ++b) acc[b] = 0.f;
        for (int k = ks * 128; k < ks * 128 + 128; ++k) { const float w = wm[(size_t)k * 6144];
#pragma unroll
            for (int b = 0; b < 17; ++b) acc[b] += sc[k * 20 + b] * w; }
#pragma unroll
        for (int b = 0; b < 17; ++b) red[(ks * 17 + b) * 64 + j] = acc[b];
        __syncthreads();
        for (int b = ks; b < 17; b += 8) { float s = 0.f;
#pragma unroll
            for (int q = 0; q < 8; ++q) s += red[(q * 17 + b) * 64 + j];
            MOD[((size_t)l * 17 + b) * 6144 + col0 + j] = s + a.in[5][l * 6144 + col0 + j]; }
        __syncthreads();
    }
    const int gt = blockIdx.x * NTHREADS + tid, ngt = G * NTHREADS;
    float* rc = (float*)(ws + WS_ROPE); float* rs = rc + 2048 * 32;
    for (int i = gt; i < 2048 * 32; i += ngt) { const int t = i >> 5, f = i & 31; const float pos = (f < 16) ? (float)(t >> 6) : (float)(t & 63);
        const float inv = powf(10000.0f, -(float)(f & 15) / 16.0f); const float ang = pos * inv; rc[i] = cosf(ang); rs[i] = sinf(ang); }
    float* misc = (float*)(ws + WS_MISC);
    if (gt < 2) { const int l = gt; float s1 = 0.f, s2 = 0.f;
        for (int i = 0; i < 64; ++i) { s1 += a.in[9][l * 64 + i] * a.in[10][l * 64 + i]; s2 += a.in[11][l * 64 + i] * a.in[12][l * 64 + i]; }
        misc[l] = expf(s1) - expf(s2) + (0.8f - 0.6f * expf(-0.3f * (float)l)); }
    for (int i = gt; i < 1024; i += ngt) { const float a0 = a.in[14][i], a1 = a.in[14][1024 + i]; misc[256 + i] = 0.f; misc[256 + 1024 + i] = 1.0f / (1.0f + expf(a0 - a1)); }
}

struct RowRef { const float* src; float* dst; int bidx; bool lat; };
__device__ __forceinline__ RowRef row_ref(const Args& a, int l, int g, int row) {
    const int bl = row / TPB, pos = row % TPB, bgl = g * NBG + bl; RowRef r; r.lat = pos >= CTXL;
    if (r.lat) { const size_t xr = (size_t)bgl * SEQ + (pos - CTXL); r.src = ((l == 0) ? a.in[0] : a.out) + xr * 1024; r.dst = a.out + xr * 1024; r.bidx = bgl; }
    else { const size_t xr = (size_t)bgl * CTXL + pos; float* xc = (float*)(a.ws + WS_XC); r.src = ((l == 0) ? a.in[2] : xc) + xr * 1024; r.dst = xc + xr * 1024; r.bidx = 16; }
    return r;
}
__device__ __forceinline__ void phase_norm1(const Args& a, int l, int g, int gw, int ngw, int lane) {
    bf16* H = (bf16*)(a.ws + WS_AR); const float* MOD = (const float*)(a.ws + WS_MOD) + (size_t)l * 17 * 6144; const float* g1 = a.in[6] + l * 1024;
    for (int row = gw; row < GT; row += ngw) {
        const RowRef rr = row_ref(a, l, g, row);
        const f32x4* xr = (const f32x4*)rr.src + lane; f32x4 v[4]; float s = 0.f;
#pragma unroll
        for (int j = 0; j < 4; ++j) { v[j] = xr[64 * j]; s += (v[j].x * v[j].x + v[j].y * v[j].y) + (v[j].z * v[j].z + v[j].w * v[j].w); }
        const float rstd = rsqrtf(wave_sum(s) * (1.f / D) + EPS);
        const float* sh = MOD + (size_t)rr.bidx * 6144; const float* scl = sh + 1024;
        v2u* o = (v2u*)(H + (size_t)row * 1024) + lane;
#pragma unroll
        for (int j = 0; j < 4; ++j) { const int c = (64 * j + lane) * 4; const f32x4 gg = *(const f32x4*)(g1 + c), ss = *(const f32x4*)(scl + c), hh = *(const f32x4*)(sh + c);
            const f32x4 y = v[j] * rstd * gg * (ss + 1.0f) + hh; v2u w; w.x = pk2(y.x, y.y); w.y = pk2(y.z, y.w); o[64 * j] = w; }
    }
}
__device__ __forceinline__ void phase_rprep(const Args& a, int l, int gw, int ngw, int lane) {
    bf16* AR = (bf16*)(a.ws + WS_AR); const bf16* OB = (const bf16*)(a.ws + WS_OB); const bf16* SRG = (const bf16*)(a.ws + WS_PROJ) + 7 * SEG_ELEMS; const float* grec = a.in[15] + l * 128;
    const int nrows = (l == NLAYER - 1) ? NBG * SEQ : GT;
    for (int i = gw; i < nrows; i += ngw) {
        const int row = (l == NLAYER - 1) ? (i / SEQ) * TPB + CTXL + (i % SEQ) : i;
#pragma unroll
        for (int j = 0; j < 2; ++j) { const int c = j * 512 + lane * 8;
            const v4u f = *(const v4u*)(AR + (size_t)row * 2048 + 1024 + c), b = *(const v4u*)(OB + (size_t)row * 1024 + c), sg = *(const v4u*)(SRG + (size_t)row * 1024 + c);
            float v[8]; v[0] = bflo(f.x) + bflo(b.x); v[1] = bfhi(f.x) + bfhi(b.x); v[2] = bflo(f.y) + bflo(b.y); v[3] = bfhi(f.y) + bfhi(b.y);
            v[4] = bflo(f.z) + bflo(b.z); v[5] = bfhi(f.z) + bfhi(b.z); v[6] = bflo(f.w) + bflo(b.w); v[7] = bfhi(f.w) + bfhi(b.w);
            float s = 0.f;
#pragma unroll
            for (int q = 0; q < 8; ++q) s += v[q] * v[q];
            s += __shfl_xor(s, 1); s += __shfl_xor(s, 2); s += __shfl_xor(s, 4); s += __shfl_xor(s, 8);
            const float rstd = rsqrtf(s * (1.f / 128.f) + EPS);
            const f32x4 g0 = *(const f32x4*)(grec + (c & 127)), g1 = *(const f32x4*)(grec + (c & 127) + 4);
            v4u w; w.x = pk2(v[0] * rstd * g0.x * bflo(sg.x), v[1] * rstd * g0.y * bfhi(sg.x)); w.y = pk2(v[2] * rstd * g0.z * bflo(sg.y), v[3] * rstd * g0.w * bfhi(sg.y));
            w.z = pk2(v[4] * rstd * g1.x * bflo(sg.z), v[5] * rstd * g1.y * bfhi(sg.z)); w.w = pk2(v[6] * rstd * g1.z * bflo(sg.w), v[7] * rstd * g1.w * bfhi(sg.w));
            *(v4u*)(AR + (size_t)row * 2048 + 1024 + c) = w; }
    }
}
__device__ __forceinline__ int moe_row(int l, int i) { return (l == NLAYER - 1) ? (i / SEQ) * TPB + CTXL + (i % SEQ) : i; }
__device__ __forceinline__ int moe_nrows(int l) { return (l == NLAYER - 1) ? NBG * SEQ : GT; }
__device__ __forceinline__ void h2_row(const Args& a, int l, const RowRef& rr, int lane, f32x4 (&v)[4]) {
    const f32x4* xr = (const f32x4*)rr.src + lane; float s = 0.f;
    (void)xr; const f32x4* xd = (const f32x4*)rr.dst + lane;
#pragma unroll
    for (int j = 0; j < 4; ++j) { v[j] = xd[64 * j]; s += (v[j].x * v[j].x + v[j].y * v[j].y) + (v[j].z * v[j].z + v[j].w * v[j].w); }
    const float rstd = rsqrtf(wave_sum(s) * (1.f / D) + EPS);
    const float* MOD = (const float*)(a.ws + WS_MOD) + (size_t)l * 17 * 6144 + (size_t)rr.bidx * 6144; const float* g2 = a.in[7] + l * 1024;
#pragma unroll
    for (int j = 0; j < 4; ++j) { const int c = (64 * j + lane) * 4; const f32x4 gg = *(const f32x4*)(g2 + c), ss = *(const f32x4*)(MOD + 4 * 1024 + c), hh = *(const f32x4*)(MOD + 3 * 1024 + c);
        v[j] = v[j] * rstd * gg * (ss + 1.0f) + hh; }
}
__device__ __forceinline__ void phase_route(const Args& a, int l, int g, LAS unsigned char* lds, int tid, int gw, int ngw, int lane) {
    LAS float* wrt = (LAS float*)lds;
    for (int i = tid; i < 16 * 1024; i += NTHREADS) { const int c = i >> 4, e = i & 15; wrt[e * 1024 + c] = a.in[19][i]; }
    __syncthreads();
    unsigned* cnt = (unsigned*)(a.ws + WS_CTL) + CW_CNT + (l * NGRP + g) * 16 * 64;
    int* rte = (int*)(a.ws + WS_ROUTE + RT_E); int* rtp = (int*)(a.ws + WS_ROUTE + RT_P); float* rtw = (float*)(a.ws + WS_ROUTE + RT_W);
    const int nrows = moe_nrows(l);
    for (int i = gw; i < nrows; i += ngw) {
        const int row = moe_row(l, i); const RowRef rr = row_ref(a, l, g, row);
        f32x4 v[4]; h2_row(a, l, rr, lane, v);
        float sc[16];
#pragma unroll
        for (int e = 0; e < 16; ++e) { float p = 0.f;
#pragma unroll
            for (int j = 0; j < 4; ++j) { const f32x4 w = *(const LAS f32x4*)(wrt + e * 1024 + (64 * j + lane) * 4); p += (v[j].x * w.x + v[j].y * w.y) + (v[j].z * w.z + v[j].w * w.w); }
            sc[e] = sigmoidf_(wave_sum(p)); asm volatile("" ::: "memory"); }
        float bs[16];
#pragma unroll
        for (int e = 0; e < 16; ++e) bs[e] = sc[e] + a.in[20][e];
        int grp = 0; float best = -1e30f;
#pragma unroll
        for (int q = 0; q < 4; ++q) { float t1 = -1e30f, t2 = -1e30f;
#pragma unroll
            for (int e = 0; e < 4; ++e) { const float x = bs[4 * q + e]; if (x > t1) { t2 = t1; t1 = x; } else if (x > t2) t2 = x; }
            const float gs = t1 + t2; if (gs > best) { best = gs; grp = q; } }
        float ib[4], is[4];
#pragma unroll
        for (int e = 0; e < 4; ++e) { ib[e] = (grp == 0) ? bs[e] : (grp == 1) ? bs[4 + e] : (grp == 2) ? bs[8 + e] : bs[12 + e]; is[e] = (grp == 0) ? sc[e] : (grp == 1) ? sc[4 + e] : (grp == 2) ? sc[8 + e] : sc[12 + e]; }
        int i1 = 0; float b1 = ib[0], s1 = is[0];
#pragma unroll
        for (int e = 1; e < 4; ++e) if (ib[e] > b1) { b1 = ib[e]; i1 = e; s1 = is[e]; }
        int i2 = -1; float b2 = -1e30f, s2 = 0.f;
#pragma unroll
        for (int e = 0; e < 4; ++e) if (e != i1 && ib[e] > b2) { b2 = ib[e]; i2 = e; s2 = is[e]; }
        const int e1 = grp * 4 + i1, e2 = grp * 4 + i2;
        if (lane == 0) { const unsigned p1 = __hip_atomic_fetch_add(cnt + e1 * 64, 1u, RLX_AGENT), p2 = __hip_atomic_fetch_add(cnt + e2 * 64, 1u, RLX_AGENT);
            rte[2 * i] = e1; rte[2 * i + 1] = e2; rtp[2 * i] = (int)p1; rtp[2 * i + 1] = (int)p2; const float inv = 1.0f / (s1 + s2); rtw[2 * i] = s1 * inv; rtw[2 * i + 1] = s2 * inv; }
    }
}
__device__ __forceinline__ void phase_scatter(const Args& a, int l, int g, int gw, int ngw, int lane) {
    unsigned* cnt = (unsigned*)(a.ws + WS_CTL) + CW_CNT + (l * NGRP + g) * 16 * 64;
    const int* rte = (const int*)(a.ws + WS_ROUTE + RT_E); const int* rtp = (const int*)(a.ws + WS_ROUTE + RT_P); int* rts = (int*)(a.ws + WS_ROUTE + RT_S);
    bf16* H2S = (bf16*)(a.ws + WS_H2S);
    int pc = 0; if (lane < 16) pc = ((int)__hip_atomic_load(cnt + lane * 64, RLX_AGENT) + 255) & ~255;
    int incl = pc;
#pragma unroll
    for (int o = 1; o < 16; o <<= 1) { const int t = __shfl_up(incl, o); if (lane >= o) incl += t; }
    const int excl = incl - pc;
    if (gw == 0) { int* te = (int*)(a.ws + WS_MISC + 16384);
        if (lane < 16) for (int t = excl >> 8; t < (incl >> 8); ++t) te[t] = lane;
        if (lane == 15) te[256] = incl >> 8; }
    const int nrows = moe_nrows(l);
    for (int i = gw; i < nrows; i += ngw) {
        const int row = moe_row(l, i); const RowRef rr = row_ref(a, l, g, row);
        f32x4 v[4]; h2_row(a, l, rr, lane, v);
        const int e1 = ldg_i(rte + 2 * i), e2 = ldg_i(rte + 2 * i + 1);
        const int s1 = __shfl(excl, e1) + ldg_i(rtp + 2 * i), s2 = __shfl(excl, e2) + ldg_i(rtp + 2 * i + 1);
        if (lane == 0) { rts[2 * i] = s1; rts[2 * i + 1] = s2; }
        v2u* o1 = (v2u*)(H2S + (size_t)s1 * 1024) + lane; v2u* o2 = (v2u*)(H2S + (size_t)s2 * 1024) + lane;
#pragma unroll
        for (int j = 0; j < 4; ++j) { v2u w; w.x = pk2(v[j].x, v[j].y); w.y = pk2(v[j].z, v[j].w); o1[64 * j] = w; o2[64 * j] = w; }
    }
}
__device__ __forceinline__ void phase_combine(const Args& a, int l, int g, int gw, int ngw, int lane) {
    const int* rts = (const int*)(a.ws + WS_ROUTE + RT_S); const float* rtw = (const float*)(a.ws + WS_ROUTE + RT_W); const bf16* YE = (const bf16*)(a.ws + WS_YE);
    const float* MODL = (const float*)(a.ws + WS_MOD) + (size_t)l * 17 * 6144;
    const int nrows = moe_nrows(l);
    for (int i = gw; i < nrows; i += ngw) {
        const int row = moe_row(l, i); const RowRef rr = row_ref(a, l, g, row);
        const int s1 = ldg_i(rts + 2 * i), s2 = ldg_i(rts + 2 * i + 1); const float w1 = ldg_f(rtw + 2 * i), w2 = ldg_f(rtw + 2 * i + 1);
        const float* gate = MODL + (size_t)rr.bidx * 6144 + 5 * 1024;
        f32x4* xd = (f32x4*)rr.dst + lane; const v2u* y1 = (const v2u*)(YE + (size_t)s1 * 1024) + lane; const v2u* y2 = (const v2u*)(YE + (size_t)s2 * 1024) + lane;
        f32x4 v[4]; float s = 0.f;
#pragma unroll
        for (int j = 0; j < 4; ++j) { const f32x4 x = xd[64 * j]; const v2u p = y1[64 * j], q = y2[64 * j]; const f32x4 gg = *(const f32x4*)(gate + (64 * j + lane) * 4);
            f32x4 y; y.x = w1 * bflo(p.x) + w2 * bflo(q.x); y.y = w1 * bfhi(p.x) + w2 * bfhi(q.x); y.z = w1 * bflo(p.y) + w2 * bflo(q.y); y.w = w1 * bfhi(p.y) + w2 * bfhi(q.y);
            v[j] = x + gg * y; s += (v[j].x * v[j].x + v[j].y * v[j].y) + (v[j].z * v[j].z + v[j].w * v[j].w); }
        if (l == NLAYER - 1) { const float rstd = rsqrtf(wave_sum(s) * (1.f / D) + EPS);
#pragma unroll
            for (int j = 0; j < 4; ++j) xd[64 * j] = v[j] * rstd * *(const f32x4*)(a.in[24] + (64 * j + lane) * 4); }
        else {
#pragma unroll
            for (int j = 0; j < 4; ++j) xd[64 * j] = v[j]; }
    }
}

__device__ __forceinline__ unsigned off_b(unsigned row, unsigned ch) { return 256u * row + 16u * (ch ^ (((row & 3u) << 2) | ((row >> 2) & 3u))); }
typedef __attribute__((address_space(3))) const unsigned char* lds_cptr;
__device__ __forceinline__ s16x4 vtr(lds_cptr p) { return __builtin_bit_cast(s16x4, __builtin_amdgcn_ds_read_tr16_b64_v4i16((__attribute__((address_space(3))) s16x4*)p)); }
typedef __bf16 bf16x2_t __attribute__((ext_vector_type(2)));
__device__ __forceinline__ unsigned cvtpk(float lo, float hi) { f32x2 v = {lo, hi}; bf16x2_t b = __builtin_convertvector(v, bf16x2_t); return __builtin_bit_cast(unsigned, b); }

__device__ __forceinline__ void scan_unit(const Args& a, LAS unsigned char* lds, int tid, int bl, int h, int dir) {
    const bf16* P = (const bf16*)(a.ws + WS_PROJ);
    const bf16* RQ = P + 3 * SEG_ELEMS; const bf16* GG = P + (size_t)(4 + dir) * SEG_ELEMS; const bf16* RI = P + 6 * SEG_ELEMS;
    bf16* OUT = dir ? (bf16*)(a.ws + WS_OB) : (bf16*)(a.ws + WS_AR) + 1024; const int ldo = dir ? 1024 : 2048;
    LAS float* F = (LAS float*)lds; LAS float* KK = F + 4096; LAS float* QS = KK + 4096; LAS float* VS = QS + 4096; LAS float* OP = VS + 4096;
    const int e = tid & 127, dq = tid >> 7, sstep = tid >> 4, sch = tid & 15;
    float S[32];
#pragma unroll
    for (int i = 0; i < 32; ++i) S[i] = 0.f;
    const size_t rowbase = (size_t)bl * TPB;
    for (int tb = 0; tb < TPB / 32; ++tb) {
        { const int tau = tb * 32 + sstep; const int pos = dir ? ((tau < CTXL) ? (CTXL - 1 - tau) : (TPB - 1 - (tau - CTXL))) : tau;
          const size_t off = (rowbase + pos) * 1024 + h * 128 + sch * 8;
          const v4u gq = *(const v4u*)(GG + off), qq = *(const v4u*)(RQ + off), vv = *(const v4u*)(RI + off);
          float gv[8] = {bflo(gq.x), bfhi(gq.x), bflo(gq.y), bfhi(gq.y), bflo(gq.z), bfhi(gq.z), bflo(gq.w), bfhi(gq.w)};
          float qv[8] = {bflo(qq.x), bfhi(qq.x), bflo(qq.y), bfhi(qq.y), bflo(qq.z), bfhi(qq.z), bflo(qq.w), bfhi(qq.w)};
          float vv8[8] = {bflo(vv.x), bfhi(vv.x), bflo(vv.y), bfhi(vv.y), bflo(vv.z), bfhi(vv.z), bflo(vv.w), bfhi(vv.w)};
#pragma unroll
          for (int i = 0; i < 8; ++i) { const float f = __expf(gv[i]); F[sstep * 128 + sch * 8 + i] = f; KK[sstep * 128 + sch * 8 + i] = 1.0f - f; QS[sstep * 128 + sch * 8 + i] = qv[i]; VS[sstep * 128 + sch * 8 + i] = vv8[i]; } }
        __syncthreads();
        for (int st = 0; st < 32; ++st) {
            const float v = VS[st * 128 + e]; float acc = 0.f;
            const LAS f32x4* f4 = (const LAS f32x4*)(F + st * 128 + dq * 32); const LAS f32x4* k4 = (const LAS f32x4*)(KK + st * 128 + dq * 32); const LAS f32x4* q4 = (const LAS f32x4*)(QS + st * 128 + dq * 32);
#pragma unroll
            for (int i = 0; i < 8; ++i) { const f32x4 ff = f4[i], kk = k4[i], qq = q4[i];
                S[4 * i + 0] = ff.x * S[4 * i + 0] + kk.x * v; acc += S[4 * i + 0] * qq.x;
                S[4 * i + 1] = ff.y * S[4 * i + 1] + kk.y * v; acc += S[4 * i + 1] * qq.y;
                S[4 * i + 2] = ff.z * S[4 * i + 2] + kk.z * v; acc += S[4 * i + 2] * qq.z;
                S[4 * i + 3] = ff.w * S[4 * i + 3] + kk.w * v; acc += S[4 * i + 3] * qq.w; }
            OP[(dq * 32 + st) * 128 + e] = acc;
        }
        __syncthreads();
#pragma unroll
        for (int j = 0; j < 8; ++j) { const int st = dq + 4 * j; const float o = (OP[(0 * 32 + st) * 128 + e] + OP[(1 * 32 + st) * 128 + e]) + (OP[(2 * 32 + st) * 128 + e] + OP[(3 * 32 + st) * 128 + e]);
            const int tau = tb * 32 + st; const int pos = dir ? ((tau < CTXL) ? (CTXL - 1 - tau) : (TPB - 1 - (tau - CTXL))) : tau;
            OUT[(rowbase + pos) * ldo + h * 128 + e] = (bf16)f2bf(o); }
    }
    __syncthreads();
}

#define ATT_THR 4.0f
__device__ __forceinline__ void attn_unit(const Args& a, LAS unsigned char* lds, int tid, int l, int bl, int h, int qb) {
    const bf16* P = (const bf16*)(a.ws + WS_PROJ);
    const bf16* Q = P; const bf16* K = P + SEG_ELEMS; const bf16* V = P + 2 * SEG_ELEMS; bf16* AR = (bf16*)(a.ws + WS_AR);
    const int lane = tid & 63, wid = __builtin_amdgcn_readfirstlane(tid >> 6), r32 = lane & 31, hi = lane >> 5, mp = wid >> 2, qs = wid & 3;
    const size_t rowbase = (size_t)bl * TPB; const int nkt = (qb < 2) ? (CTXL / 64) : (TPB / 64);
    const size_t qrow = rowbase + 128 * qb + 32 * qs + r32;
    bf16x8 qr[4];
#pragma unroll
    for (int d0 = 0; d0 < 4; ++d0) qr[d0] = *(const bf16x8*)(Q + qrow * 1024 + h * 128 + mp * 64 + d0 * 16 + hi * 8);
    const int srow = tid >> 4, sch = tid & 15;
    const bf16* Kg = K + (rowbase + srow) * 1024 + h * 128 + sch * 8; const bf16* Vg = V + (rowbase + srow) * 1024 + h * 128 + sch * 8;
    const unsigned so0 = off_b(srow, sch), so1 = off_b(32 + srow, sch);
    v4u kr0, kr1, vr0, vr1;
#define ATT_GLOAD(t) do { kr0 = *(const v4u*)(Kg + (size_t)(64 * (t)) * 1024); kr1 = *(const v4u*)(Kg + (size_t)(64 * (t) + 32) * 1024); vr0 = *(const v4u*)(Vg + (size_t)(64 * (t)) * 1024); vr1 = *(const v4u*)(Vg + (size_t)(64 * (t) + 32) * 1024); } while (0)
#define ATT_SWRITE(buf) do { LAS unsigned char* b_ = lds + (buf) * 32768; *(LAS v4u*)(b_ + so0) = kr0; *(LAS v4u*)(b_ + so1) = kr1; *(LAS v4u*)(b_ + 16384 + so0) = vr0; *(LAS v4u*)(b_ + 16384 + so1) = vr1; } while (0)
    f32x16 o[4];
#pragma unroll
    for (int c = 0; c < 4; ++c)
#pragma unroll
        for (int r = 0; r < 16; ++r) o[c][r] = 0.f;
    float m_run = -1e30f, l_run = 0.f;
    const int q4 = (lane & 15) >> 2, blk = (lane >> 4) & 1, pp = lane & 3;
    ATT_GLOAD(0); ATT_SWRITE(0); __syncthreads();
    for (int t = 0; t < nkt; ++t) {
        if (t + 1 < nkt) ATT_GLOAD(t + 1);
        const LAS unsigned char* Kb = lds + (t & 1) * 32768; const LAS unsigned char* Vb = Kb + 16384;
        f32x16 p0, p1;
#pragma unroll
        for (int r = 0; r < 16; ++r) { p0[r] = 0.f; p1[r] = 0.f; }
#pragma unroll
        for (int d0 = 0; d0 < 4; ++d0) {
            const bf16x8 a0 = *(const LAS bf16x8*)(Kb + off_b(r32, mp * 8 + 2 * d0 + hi)), a1 = *(const LAS bf16x8*)(Kb + off_b(32 + r32, mp * 8 + 2 * d0 + hi));
            p0 = __builtin_amdgcn_mfma_f32_32x32x16_bf16(a0, qr[d0], p0, 0, 0, 0); p1 = __builtin_amdgcn_mfma_f32_32x32x16_bf16(a1, qr[d0], p1, 0, 0, 0); }
        float mx = fmaxf(p0[0], p1[0]);
#pragma unroll
        for (int r = 1; r < 16; ++r) mx = fmaxf(mx, fmaxf(p0[r], p1[r]));
        mx = fmaxf(mx, __shfl_xor(mx, 32));
        if (__any(mx > m_run + ATT_THR)) { const float mn = fmaxf(m_run, mx), al = __builtin_amdgcn_exp2f(m_run - mn); l_run *= al; m_run = mn;
#pragma unroll
            for (int c = 0; c < 4; ++c)
#pragma unroll
                for (int r = 0; r < 16; ++r) o[c][r] *= al; }
        float ls = 0.f;
#pragma unroll
        for (int r = 0; r < 16; ++r) { p0[r] = __builtin_amdgcn_exp2f(p0[r] - m_run); p1[r] = __builtin_amdgcn_exp2f(p1[r] - m_run); ls += p0[r] + p1[r]; }
        l_run += ls;
        bf16x8 pb[4];
        { v4u w; w.x = cvtpk(p0[0], p0[1]); w.y = cvtpk(p0[2], p0[3]); w.z = cvtpk(p0[4], p0[5]); w.w = cvtpk(p0[6], p0[7]); pb[0] = __builtin_bit_cast(bf16x8, w);
          w.x = cvtpk(p0[8], p0[9]); w.y = cvtpk(p0[10], p0[11]); w.z = cvtpk(p0[12], p0[13]); w.w = cvtpk(p0[14], p0[15]); pb[1] = __builtin_bit_cast(bf16x8, w);
          w.x = cvtpk(p1[0], p1[1]); w.y = cvtpk(p1[2], p1[3]); w.z = cvtpk(p1[4], p1[5]); w.w = cvtpk(p1[6], p1[7]); pb[2] = __builtin_bit_cast(bf16x8, w);
          w.x = cvtpk(p1[8], p1[9]); w.y = cvtpk(p1[10], p1[11]); w.z = cvtpk(p1[12], p1[13]); w.w = cvtpk(p1[14], p1[15]); pb[3] = __builtin_bit_cast(bf16x8, w); }
#pragma unroll
        for (int c = 0; c < 4; ++c)
#pragma unroll
            for (int s = 0; s < 4; ++s) {
                const unsigned chn = 4 * c + 2 * blk + (pp >> 1), bo = 8 * (pp & 1);
                const s16x4 lo = vtr((lds_cptr)(Vb + off_b(16 * s + 4 * hi + q4, chn) + bo)), hh = vtr((lds_cptr)(Vb + off_b(16 * s + 8 + 4 * hi + q4, chn) + bo));
                const bf16x8 va = {lo[0], lo[1], lo[2], lo[3], hh[0], hh[1], hh[2], hh[3]};
                o[c] = __builtin_amdgcn_mfma_f32_32x32x16_bf16(va, pb[s], o[c], 0, 0, 0); }
        if (t + 1 < nkt) ATT_SWRITE((t + 1) & 1);
        __syncthreads();
    }
#undef ATT_GLOAD
#undef ATT_SWRITE
    l_run += __shfl_xor(l_run, 32);
    const float inv = 1.0f / l_run;
    LAS float* X = (LAS float*)lds;
    if (mp == 1) {
#pragma unroll
        for (int c = 0; c < 4; ++c)
#pragma unroll
            for (int r = 0; r < 16; ++r) X[((qs * 4 + c) * 16 + r) * 64 + lane] = o[c][r] * inv;
    }
    __syncthreads();
    if (mp == 0) {
        const float lam = ((const float*)(a.ws + WS_MISC))[l]; const float osc = 1.0f - (0.8f - 0.6f * __expf(-0.3f * (float)l));
        float ss = 0.f;
#pragma unroll
        for (int c = 0; c < 4; ++c)
#pragma unroll
            for (int r = 0; r < 16; ++r) { const float v = o[c][r] * inv - lam * X[((qs * 4 + c) * 16 + r) * 64 + lane]; o[c][r] = v; ss += v * v; }
        ss += __shfl_xor(ss, 32);
        const float rstd = rsqrtf(ss * (1.f / 128.f) + EPS) * osc; const float* gs = a.in[13] + l * 128;
#pragma unroll
        for (int c = 0; c < 4; ++c)
#pragma unroll
            for (int rg = 0; rg < 4; ++rg) { const int dv = 32 * c + 8 * rg + 4 * hi; const f32x4 g4 = *(const f32x4*)(gs + dv);
                v2u w; w.x = pk2(o[c][4 * rg] * rstd * g4.x, o[c][4 * rg + 1] * rstd * g4.y); w.y = pk2(o[c][4 * rg + 2] * rstd * g4.z, o[c][4 * rg + 3] * rstd * g4.w);
                *(v2u*)(AR + qrow * 2048 + h * 128 + dv) = w; }
    }
    __syncthreads();
}

__device__ __forceinline__ void phase_mixer(const Args& a, int l, int g, LAS unsigned char* lds, volatile LAS unsigned* misc, int tid) {
    unsigned* head = (unsigned*)(a.ws + WS_CTL) + CW_QUEUE + 64 * (l * NGRP + g);
    const int nscan = NBG * 8 * 2, nqb = (l == 0) ? 18 : 16, natt = NBG * 8 * nqb;
    for (;;) {
        if (tid == 0) misc[0] = __hip_atomic_fetch_add(head, 1u, RLX_AGENT);
        __syncthreads();
        const int u = (int)misc[0];
        __syncthreads();
        if (u >= nscan + natt) break;
        if (u < nscan) scan_unit(a, lds, tid, u >> 4, (u >> 1) & 7, u & 1);
        else { const int v = u - nscan; const int qi = v % nqb, bh = v / nqb; attn_unit(a, lds, tid, l, bh >> 3, bh & 7, (l == 0) ? qi : qi + 2); }
    }
}

#ifndef MK_SINGLE
#define MK_SINGLE 1
#endif
constexpr int PH_PER_GROUP = 11;
constexpr int N_PHASES = 1 + NLAYER * NGRP * PH_PER_GROUP;

__global__ void __launch_bounds__(NTHREADS, 2) fwd_kernel(Args args) {
    extern __shared__ __attribute__((aligned(16))) unsigned char lds_raw[];
    LAS unsigned char* lds = (LAS unsigned char*)lds_raw;
    volatile LAS unsigned* MISC = (volatile LAS unsigned*)(lds + MISC_OFF);
    const int G = gridDim.x, bx = blockIdx.x, vcu = (G % 8 == 0) ? (bx % 8) * (G / 8) + bx / 8 : bx;
    const int ngw = G * NWAVES;
#define IDS() int tid_ = threadIdx.x; asm volatile("" : "+v"(tid_)); const int tid = tid_, lane = tid & 63, wave = __builtin_amdgcn_readfirstlane(tid >> 6), gw = vcu * NWAVES + wave; (void)lane; (void)gw; (void)wave
    unsigned char* ws = args.ws;
    unsigned* ctl = (unsigned*)(ws + WS_CTL);
    for (int u = threadIdx.x; u < (LDS_BYTES - LDSCTL_OFF) / 4; u += NTHREADS) ((LAS unsigned*)(lds + LDSCTL_OFF))[u] = 0u;
    __syncthreads();
    const int lo = args.ph_lo, hi = args.ph_hi;
    XcdBarrier bar; bar.bar = ctl + CW_BAR; bar.x = 0; bar.st = nullptr;
    if (hi - lo > 1) bar = xcd_barrier_post(ctl + CW_BAR, MISC + 8);
#define IN(k) (lo <= (k) && (k) < hi)
#define SEAM(k) do { if (IN(k) && IN((k) + 1)) xcd_barrier(bar); } while (0)

    int pid = 0;
    if (IN(pid)) { { IDS(); phase_prologue(args, lds, tid, G); } { IDS(); phase_weights(args, 0, lds, gw, ngw, wave, lane); } }
    SEAM(pid); ++pid;

    for (int l = 0; l < NLAYER; ++l) {
        for (int g = 0; g < NGRP; ++g) {
            const int mode = (l == NLAYER - 1) ? 1 : 0;
            if (IN(pid)) { IDS(); phase_norm1(args, l, g, gw, ngw, lane); }
            SEAM(pid); ++pid;
            if (IN(pid)) {
                pg8::Gemm gm{(const bf16*)(ws + WS_AR), (const bf16*)(ws + WS_WIN), GT, NIN, 1024};
                DenseOrder S; S.init((l == NLAYER - 1) ? 2 : 0, NIN / 256, G, bx);
                EpiInProj E{(bf16*)(ws + WS_PROJ), (const float*)(ws + WS_ROPE), (const float*)(ws + WS_ROPE) + 2048 * 32, (const float*)(ws + WS_MISC) + 256 + l * 1024};
                pg8::gemm_phase<EpiInProj, DenseOrder, true, true>(lds, gm, S, E);
            }
            SEAM(pid); ++pid;
            if (IN(pid)) { IDS(); phase_mixer(args, l, g, lds, MISC, tid); }
            SEAM(pid); ++pid;
            if (IN(pid)) { IDS(); phase_rprep(args, l, gw, ngw, lane); }
            SEAM(pid); ++pid;
            if (IN(pid)) {
                pg8::Gemm gm{(const bf16*)(ws + WS_AR), (const bf16*)(ws + WS_WAR), GT, 1024, 2048};
                DenseOrder S; S.init(mode, 4, G, bx);
                EpiMix E{(const bf16*)(ws + WS_PROJ) + 8 * SEG_ELEMS, (const bf16*)(ws + WS_PROJ) + 9 * SEG_ELEMS, (bf16*)(ws + WS_MIX)};
                pg8::gemm_phase<EpiMix, DenseOrder, true, true>(lds, gm, S, E);
            }
            SEAM(pid); ++pid;
            if (IN(pid)) {
                pg8::Gemm gm{(const bf16*)(ws + WS_MIX), (const bf16*)(ws + WS_WO), GT, 1024, 1024};
                DenseOrder S; S.init(mode, 4, G, bx);
                EpiOut E{(l == 0) ? args.in[0] : args.out, args.out, (l == 0) ? args.in[2] : (const float*)(ws + WS_XC), (float*)(ws + WS_XC), (const float*)(ws + WS_MOD) + (size_t)l * 17 * 6144, g * NBG};
                pg8::gemm_phase<EpiOut, DenseOrder, true, true>(lds, gm, S, E);
            }
            SEAM(pid); ++pid;
            if (IN(pid)) { IDS(); phase_route(args, l, g, lds, tid, gw, ngw, lane); }
            SEAM(pid); ++pid;
            if (IN(pid)) { IDS(); phase_scatter(args, l, g, gw, ngw, lane); }
            SEAM(pid); ++pid;
            if (IN(pid)) {
                const int* te = (const int*)(ws + WS_MISC + 16384); const int nt = (int)__hip_atomic_load((const unsigned*)te + 256, RLX_AGENT);
                pg8::Gemm gm{(const bf16*)(ws + WS_H2S), (const bf16*)(ws + WS_WUP), MAXSLOT, 2048, 1024};
                MoeOrder<8> S; S.init(te, nt, G, vcu);
                EpiUp E{(bf16*)(ws + WS_HID)};
                pg8::gemm_phase<EpiUp, MoeOrder<8>, true, true>(lds, gm, S, E);
            }
            SEAM(pid); ++pid;
            if (IN(pid)) {
                const int* te = (const int*)(ws + WS_MISC + 16384); const int nt = (int)__hip_atomic_load((const unsigned*)te + 256, RLX_AGENT);
                pg8::Gemm gm{(const bf16*)(ws + WS_HID), (const bf16*)(ws + WS_WDN), MAXSLOT, 1024, 1024};
                MoeOrder<4> S; S.init(te, nt, G, vcu);
                EpiDown E{(bf16*)(ws + WS_YE)};
                pg8::gemm_phase<EpiDown, MoeOrder<4>, true, true>(lds, gm, S, E);
            }
            SEAM(pid); ++pid;
            if (IN(pid)) {
                { IDS(); phase_combine(args, l, g, gw, ngw, lane); }
                if (l + 1 < NLAYER && g == NGRP - 1) { IDS(); phase_weights(args, l + 1, lds, gw, ngw, wave, lane); }
            }
            SEAM(pid); ++pid;
        }
    }
#undef IN
#undef SEAM
}

extern "C" void kernel_launch(void* const* d_in, const int* in_sizes, int n_in, void* d_out, int out_size, void* d_ws, size_t ws_size, hipStream_t stream) {
    static int grid = 0;
    if (grid == 0) {
        if (n_in != 25 || out_size != NBATCH * SEQ * D || ws_size < WS_END) { fprintf(stderr, "kernel_launch: unexpected shapes (n_in %d out %d ws %zu need %zu)\n", n_in, out_size, ws_size, (size_t)WS_END); grid = -1; return; }
        int dev = 0, cus = 0, per_cu = 0;
        if (hipGetDevice(&dev) != hipSuccess || hipDeviceGetAttribute(&cus, hipDeviceAttributeMultiprocessorCount, dev) != hipSuccess) { grid = -1; return; }
        if (hipFuncSetAttribute((const void*)fwd_kernel, hipFuncAttributeMaxDynamicSharedMemorySize, LDS_BYTES) != hipSuccess) { fprintf(stderr, "kernel_launch: hipFuncSetAttribute failed\n"); grid = -1; return; }
        if (hipOccupancyMaxActiveBlocksPerMultiprocessor(&per_cu, (const void*)fwd_kernel, NTHREADS, LDS_BYTES) != hipSuccess || per_cu < 1) { fprintf(stderr, "kernel_launch: occupancy query says %d blocks per CU\n", per_cu); }
        (void)hipGetLastError();
        grid = cus;
    }
    if (grid < 0) return;
    if (hipMemsetAsync((char*)d_ws + WS_CTL, 0, CTL_ZERO_BYTES, stream) != hipSuccess) return;
    Args a{};
    for (int i = 0; i < 25; ++i) a.in[i] = (const float*)d_in[i];
    a.out = (float*)d_out; a.ws = (unsigned char*)d_ws;
#if MK_SINGLE
    a.ph_lo = 0; a.ph_hi = N_PHASES;
    hipLaunchKernelGGL(fwd_kernel, dim3(grid), dim3(NTHREADS), LDS_BYTES, stream, a);
#else
    for (int p = 0; p < N_PHASES; ++p) { a.ph_lo = p; a.ph_hi = p + 1; hipLaunchKernelGGL(fwd_kernel, dim3(grid), dim3(NTHREADS), LDS_BYTES, stream, a); }
#endif
}
```

```cpp
#include <hip/hip_runtime.h>
#include <cstdio>
#include <cstdint>
namespace pg8 {
#define PG8_LAS __attribute__((address_space(3)))
typedef unsigned short bf16_t;
typedef short bf16x8 __attribute__((ext_vector_type(8)));
typedef float f32x4 __attribute__((ext_vector_type(4)));
typedef unsigned u32x4 __attribute__((ext_vector_type(4)));
constexpr int BM = 256, BK = 64, HALF = 128, HTB = HALF * BK * 2  , STAGE_BYTES = 8 * HTB, NXCD = 8, WGM = 8;

__host__ __device__ __forceinline__ int lds_byte(int r, int c) { const int st = (r >> 4) * 2 + (c >> 5), rr = r & 15, cc = c & 31, ob = rr * 64 + cc * 2; return st * 1024 + (ob ^ (((ob >> 9) & 1) << 5)); }
__host__ __device__ __forceinline__ void stage_rc(int b, int& R, int& C) { const int st = b / 1024, sb = b % 1024, swz = sb ^ (((sb >> 9) & 1) << 5); R = (st >> 1) * 16 + swz / 64; C = (st & 1) * 32 + (swz % 64) / 2; }
__host__ __device__ __forceinline__ int perm32(int rho) { const int n = rho >> 4, i = rho & 15; return 8 * (i >> 2) + 4 * n + (i & 3); }

struct Unit { int pm, pn; };
struct Gemm { const bf16_t* A; const bf16_t* Bt; int M, N, K; };
__device__ __forceinline__ unsigned cvt_pk_bf16(float lo, float hi) { unsigned r; asm volatile("v_cvt_pk_bf16_f32 %0, %1, %2" : "=v"(r) : "v"(lo), "v"(hi)); return r; }
template <class Epi, class Sched, bool ALIGN_EPI = false, bool SP2 = false>
__device__ __forceinline__ void gemm_phase(PG8_LAS unsigned char* lds, const Gemm g, const Sched& S, const Epi& E) {
    int tid_ = threadIdx.x; asm volatile("" : "+v"(tid_));
    const int tid = tid_, wid = __builtin_amdgcn_readfirstlane(tid >> 6), lane = tid & 63, wr = wid >> 2, wc = wid & 3, fr = lane & 15, fq = lane >> 4;
    const int K = g.K, nt = K / BK;
    unsigned voffA[2], voffB[2];
#pragma unroll
    for (int i = 0; i < 2; ++i) { int R, C; stage_rc(tid * 16 + i * 8192, R, C); const int Rb = Epi::PERM ? ((R & ~31) + perm32(R & 31)) : R;
        voffA[i] = (unsigned)(R * K + C) * 2u; voffB[i] = (unsigned)(Rb * K + C) * 2u; }
    const size_t kstep = (size_t)(BK * 2);
    const size_t hstep = (size_t)HALF * K * 2;
    const size_t tstep = 2 * hstep;
    constexpr bool GA = Sched::GATHER;
    const size_t hstepA = GA ? 0 : hstep, tstepA = GA ? 0 : tstep;
    unsigned cvo[2][2], nvo[2][2];
#define PG8_GOFF(ui_, vo) do { _Pragma("unroll") for (int h_ = 0; h_ < 2; ++h_) _Pragma("unroll") for (int i_ = 0; i_ < 2; ++i_) { int R_, C_; stage_rc(tid * 16 + i_ * 8192, R_, C_); \
        vo[h_][i_] = (unsigned)S.gidx[(ui_) * 256 + h_ * 128 + R_] * (unsigned)(K * 2) + (unsigned)(C_ * 2); } } while (0)
#define PG8_STAGE_A(bufoff, gbase, H, NX) do { if constexpr (GA) { if (NX) PG8_STAGE(bufoff, gbase, nvo[H]); else PG8_STAGE(bufoff, gbase, cvo[H]); } else PG8_STAGE(bufoff, gbase, voffA); } while (0)
    const unsigned ldsw = (unsigned)wid * 1024u;
    const int aoff = lds_byte(wr * 64 + fr, fq * 8), boff = lds_byte(wc * 32 + fr, fq * 8);
#define PG8_SA(b, h) (((b) * 2 + (h)) * HTB)
#define PG8_SB(b, h) ((4 + (b) * 2 + (h)) * HTB)
#define PG8_STAGE(bufoff, gbase, voff) do { _Pragma("unroll") for (int _i = 0; _i < 2; ++_i) \
        __builtin_amdgcn_global_load_lds((const unsigned*)((const char*)(gbase) + (voff)[_i]), (PG8_LAS unsigned*)(lds + (bufoff) + ldsw + _i * 8192), 16, 0, 0); } while (0)
#define PG8_LDA(dst, b, h) do { _Pragma("unroll") for (int m = 0; m < 4; ++m) _Pragma("unroll") for (int k = 0; k < 2; ++k) dst[m][k] = *(const PG8_LAS bf16x8*)(lds + PG8_SA(b, h) + aoff + m * 2048 + k * 1024); } while (0)
#define PG8_LDB(dst, b, h) do { _Pragma("unroll") for (int n = 0; n < 2; ++n) _Pragma("unroll") for (int k = 0; k < 2; ++k) dst[n][k] = *(const PG8_LAS bf16x8*)(lds + PG8_SB(b, h) + boff + n * 2048 + k * 1024); } while (0)
#define PG8_MMA(ai, bj, At, Bt) do { __builtin_amdgcn_s_setprio(1); _Pragma("unroll") for (int m = 0; m < 4; ++m) _Pragma("unroll") for (int n = 0; n < 2; ++n) _Pragma("unroll") for (int k = 0; k < 2; ++k) \
        acc[ai][bj][m][n] = __builtin_amdgcn_mfma_f32_16x16x32_bf16(Bt[n][k], At[m][k], acc[ai][bj][m][n], 0, 0, 0); __builtin_amdgcn_s_setprio(0); } while (0)
#define PG8_WAIT_V(n) asm volatile("s_waitcnt vmcnt(" #n ")" ::: "memory")
#define PG8_WAIT_L(n) asm volatile("s_waitcnt lgkmcnt(" #n ")" ::: "memory")
#define PG8_BAR __builtin_amdgcn_s_barrier()
#define PG8_SCHED __builtin_amdgcn_sched_barrier(0)
    Unit cur, nxt; int ui = 0;
    if (!S.next(0, cur)) return;
    f32x4 acc[2][2][4][2];
#pragma unroll
    for (int a = 0; a < 2; ++a)
#pragma unroll
        for (int b = 0; b < 2; ++b)
#pragma unroll
            for (int m = 0; m < 4; ++m)
#pragma unroll
                for (int n = 0; n < 2; ++n) acc[a][b][m][n] = (f32x4){0.f, 0.f, 0.f, 0.f};
    bf16x8 At[4][2], B0[2][2], B1[2][2];
    const char* cA = (const char*)g.A + (size_t)cur.pm * tstepA; const char* cB = (const char*)g.Bt + (size_t)cur.pn * tstep;
    S.a_ready(cur);
    if constexpr (GA) { PG8_GOFF(0, cvo); }
    if constexpr (SP2) {
        PG8_STAGE(PG8_SB(0, 0), cB, voffB); PG8_STAGE(PG8_SB(0, 1), cB + hstep, voffB); PG8_STAGE_A(PG8_SA(0, 0), cA, 0, false); PG8_STAGE_A(PG8_SA(0, 1), cA + hstepA, 1, false);
        if (wr == 1) PG8_BAR;
        PG8_WAIT_V(2); PG8_BAR;
        PG8_STAGE(PG8_SB(1, 0), cB + kstep, voffB); PG8_STAGE_A(PG8_SA(1, 0), cA + kstep, 0, false); PG8_STAGE(PG8_SB(1, 1), cB + hstep + kstep, voffB);
        PG8_WAIT_V(6); PG8_BAR;
    } else {
        PG8_STAGE(PG8_SB(0, 0), cB, voffB); PG8_STAGE(PG8_SA(0, 0), cA, voffA); PG8_STAGE(PG8_SB(0, 1), cB + hstep, voffB); PG8_STAGE(PG8_SA(0, 1), cA + hstep, voffA);
        if (wr == 1) PG8_BAR;
        PG8_WAIT_V(4); PG8_BAR;
        PG8_STAGE(PG8_SB(1, 0), cB + kstep, voffB); PG8_STAGE(PG8_SA(1, 0), cA + kstep, voffA); PG8_STAGE(PG8_SB(1, 1), cB + hstep + kstep, voffB);
        PG8_WAIT_V(6); PG8_BAR;
    }
    for (;;) {
        const bool has_next = S.next(ui + 1, nxt);
        if constexpr (GA) { if (has_next) { PG8_GOFF(ui + 1, nvo); } else { _Pragma("unroll") for (int h_ = 0; h_ < 2; ++h_) _Pragma("unroll") for (int i_ = 0; i_ < 2; ++i_) nvo[h_][i_] = cvo[h_][i_]; } }
        const char* nA = has_next ? (const char*)g.A + (size_t)nxt.pm * tstepA : cA; const char* nB = has_next ? (const char*)g.Bt + (size_t)nxt.pn * tstep : cB;
        for (int t = 0; t < nt; t += 2) {
            if constexpr (Epi::HAS_MID) { if (t == (nt >> 1)) E.mid(acc, cur, wr, wc, fr, fq); }
            const bool last = (t == nt - 2);
            const char* a1 = cA + (size_t)(t + 1) * kstep;
            const char* a2 = last ? nA : cA + (size_t)(t + 2) * kstep; const char* b2 = last ? nB : cB + (size_t)(t + 2) * kstep;
            const char* a3 = a2 + kstep; const char* b3 = b2 + kstep;
            if (last && has_next) S.a_ready(nxt);
            if constexpr (SP2) {
            PG8_LDB(B0, 0, 0); PG8_LDB(B1, 0, 1); PG8_SCHED; PG8_LDA(At, 0, 0); PG8_STAGE_A(PG8_SA(1, 1), a1 + hstepA, 1, false);
            PG8_WAIT_V(8); PG8_WAIT_L(0); PG8_BAR; PG8_MMA(0, 0, At, B0); PG8_MMA(0, 1, At, B1); PG8_BAR; PG8_SCHED;
            PG8_LDA(At, 0, 1); PG8_STAGE(PG8_SB(0, 0), b2, voffB); PG8_STAGE(PG8_SB(0, 1), b2 + hstep, voffB); PG8_STAGE_A(PG8_SA(0, 0), a2, 0, last);
            PG8_WAIT_V(8); PG8_WAIT_L(0); PG8_BAR; PG8_MMA(1, 0, At, B0); PG8_MMA(1, 1, At, B1); PG8_BAR; PG8_SCHED;
            PG8_LDB(B0, 1, 0); PG8_LDB(B1, 1, 1); PG8_SCHED; PG8_LDA(At, 1, 0); PG8_STAGE_A(PG8_SA(0, 1), a2 + hstepA, 1, last);
            PG8_WAIT_V(8); PG8_WAIT_L(0); PG8_BAR; PG8_MMA(0, 0, At, B0); PG8_MMA(0, 1, At, B1); PG8_BAR; PG8_SCHED;
            PG8_LDA(At, 1, 1); PG8_STAGE(PG8_SB(1, 0), b3, voffB); PG8_STAGE(PG8_SB(1, 1), b3 + hstep, voffB); PG8_STAGE_A(PG8_SA(1, 0), a3, 0, last);
            PG8_WAIT_V(8); PG8_WAIT_L(0); PG8_BAR; PG8_MMA(1, 0, At, B0); PG8_MMA(1, 1, At, B1); PG8_BAR; PG8_SCHED;
            } else {
            PG8_LDB(B0, 0, 0); PG8_SCHED; PG8_LDA(At, 0, 0); PG8_STAGE(PG8_SA(1, 1), a1 + hstep, voffA);
            PG8_WAIT_L(8); PG8_BAR; PG8_WAIT_L(0); PG8_MMA(0, 0, At, B0); PG8_BAR; PG8_SCHED;
            PG8_LDB(B1, 0, 1); PG8_STAGE(PG8_SB(0, 0), b2, voffB);
            PG8_BAR; PG8_WAIT_L(0); PG8_MMA(0, 1, At, B1); PG8_BAR;
            PG8_LDA(At, 0, 1); PG8_STAGE(PG8_SA(0, 0), a2, voffA);
            PG8_BAR; PG8_WAIT_L(0); PG8_MMA(1, 0, At, B0); PG8_BAR; PG8_SCHED;
            PG8_STAGE(PG8_SB(0, 1), b2 + hstep, voffB);
            PG8_WAIT_V(6); PG8_BAR; PG8_MMA(1, 1, At, B1); PG8_BAR;
            PG8_LDB(B0, 1, 0); PG8_SCHED; PG8_LDA(At, 1, 0); PG8_STAGE(PG8_SA(0, 1), a2 + hstep, voffA);
            PG8_WAIT_L(8); PG8_BAR; PG8_WAIT_L(0); PG8_MMA(0, 0, At, B0); PG8_BAR; PG8_SCHED;
            PG8_LDB(B1, 1, 1); PG8_STAGE(PG8_SB(1, 0), b3, voffB);
            PG8_BAR; PG8_WAIT_L(0); PG8_MMA(0, 1, At, B1); PG8_BAR;
            PG8_LDA(At, 1, 1); PG8_STAGE(PG8_SA(1, 0), a3, voffA);
            PG8_BAR; PG8_WAIT_L(0); PG8_MMA(1, 0, At, B0); PG8_BAR; PG8_SCHED;
            PG8_STAGE(PG8_SB(1, 1), b3 + hstep, voffB);
            PG8_WAIT_V(6); PG8_BAR; PG8_MMA(1, 1, At, B1); PG8_BAR;
            }
        }
        if constexpr (ALIGN_EPI) { if (wr == 0) PG8_BAR; }
        if constexpr (!Epi::AFTER_DRAIN) { E(acc, cur, wr, wc, fr, fq); S.done(cur); }
        if (!has_next) break;
#pragma unroll
        for (int a = 0; a < 2; ++a)
#pragma unroll
            for (int b = 0; b < 2; ++b)
#pragma unroll
                for (int m = 0; m < 4; ++m)
#pragma unroll
                    for (int n = 0; n < 2; ++n) acc[a][b][m][n] = (f32x4){0.f, 0.f, 0.f, 0.f};
        cur = nxt; cA = nA; cB = nB; ++ui;
        if constexpr (GA) { _Pragma("unroll") for (int h_ = 0; h_ < 2; ++h_) _Pragma("unroll") for (int i_ = 0; i_ < 2; ++i_) cvo[h_][i_] = nvo[h_][i_]; }
        if constexpr (ALIGN_EPI) { if (wr == 1) PG8_BAR; }
    }
    PG8_WAIT_V(0);
    if constexpr (!ALIGN_EPI) { if (wr == 0) PG8_BAR; }
    PG8_BAR;
    if constexpr (Epi::AFTER_DRAIN) { E.fused(acc, cur, wr, wc, fr, fq, lds, wid, lane); S.done(cur); }
#undef PG8_SA
#undef PG8_SB
#undef PG8_STAGE
#undef PG8_STAGE_A
#undef PG8_GOFF
#undef PG8_LDA
#undef PG8_LDB
#undef PG8_MMA
#undef PG8_WAIT_V
#undef PG8_WAIT_L
#undef PG8_BAR
#undef PG8_SCHED
}
}
#define GAS __attribute__((address_space(1)))
#define LAS __attribute__((address_space(3)))
#define XB_TMO      128
#define XB_XCNT(j)  (256  + 64 * (j))
#define XB_XSUB(j)  (1280 + 64 * (j))
#define XB_XGEN(j)  (2304 + 64 * (j))
#define XB_TOP      3328
#define XB_TOPGEN   3392
#define XCD_BAR_WORDS 3456
#define XB_SPIN_CAP (1u << 18)

__device__ __forceinline__ unsigned xb_ld(unsigned* p)              { return __hip_atomic_load(p, __ATOMIC_RELAXED, __HIP_MEMORY_SCOPE_AGENT); }
__device__ __forceinline__ unsigned xb_add(unsigned* p, unsigned v) { return __hip_atomic_fetch_add(p, v, __ATOMIC_RELAXED, __HIP_MEMORY_SCOPE_AGENT); }
__device__ __forceinline__ unsigned xb_xcc_id() { return (unsigned)__builtin_amdgcn_s_getreg((3 << 11) | 20) & 0xFu; }
#define XB_SPIN(cond, bar) do { unsigned _sp = 0; while (cond) { __builtin_amdgcn_s_sleep(1); \
    if ((++_sp & 255u) == 0u) { if (xb_ld(&(bar)[XB_TMO])) break; if (_sp > XB_SPIN_CAP) { atomicAdd(&(bar)[XB_TMO], 1u); break; } } } } while (0)

struct XcdBarrier {
    unsigned* bar; unsigned x;
    volatile LAS unsigned* st;
};

__device__ __forceinline__ XcdBarrier xcd_barrier_post(unsigned* bar, volatile LAS unsigned* st) {
    XcdBarrier b; b.bar = bar; b.x = xb_xcc_id(); b.st = st;
    if (threadIdx.x == 0) (void)xb_add(&bar[XB_XCNT(b.x)], 1u);
    return b;
}
__device__ __forceinline__ void xcd_barrier_complete(unsigned* bar, unsigned x, unsigned& nloc, unsigned& nx) {
    const unsigned G = gridDim.x * gridDim.y * gridDim.z;
    unsigned sum, cnt, mine, sp = 0u;
    for (;;) {
        sum = 0u; cnt = 0u; mine = 0u;
#pragma unroll
        for (unsigned j = 0; j < 16; ++j) { const unsigned c = xb_ld(&bar[XB_XCNT(j)]); sum += c; cnt += (c > 0u) ? 1u : 0u; mine = (j == x) ? c : mine; }
        if (sum == G) break;
        __builtin_amdgcn_s_sleep(1);
        if ((++sp & 255u) == 0u) { if (xb_ld(&bar[XB_TMO])) break; if (sp > XB_SPIN_CAP) { atomicAdd(&bar[XB_TMO], 1u); break; } }
    }
    nloc = mine > 0u ? mine : 1u; nx = cnt > 0u ? cnt : 1u;
}

__device__ __forceinline__ void xcd_barrier(const XcdBarrier& b) {
    asm volatile("s_waitcnt vmcnt(0)" ::: "memory");
    __syncthreads();
    if (threadIdx.x == 0) {
        unsigned* bar = b.bar;
        __builtin_amdgcn_s_waitcnt(0);
        unsigned nloc = b.st[0], nx = b.st[1];
        if (nloc == 0u) { xcd_barrier_complete(bar, b.x, nloc, nx); b.st[0] = nloc; b.st[1] = nx; }
        const unsigned old = xb_add(&bar[XB_XSUB(b.x)], 1u);
        const unsigned gen = old / nloc;
        if (old + 1u == (gen + 1u) * nloc) {
            __builtin_amdgcn_fence(__ATOMIC_RELEASE, "agent");
            asm volatile("s_waitcnt vmcnt(0)" ::: "memory");
            const unsigned og = xb_add(&bar[XB_TOP], 1u);
            const unsigned tg = og / nx;
            if (og + 1u == (tg + 1u) * nx) xb_add(&bar[XB_TOPGEN], 1u);
            else XB_SPIN(xb_ld(&bar[XB_TOPGEN]) == tg, bar);
            __builtin_amdgcn_fence(__ATOMIC_ACQUIRE, "agent");
            xb_add(&bar[XB_XGEN(b.x)], 1u);
            asm volatile("s_waitcnt vmcnt(0)" ::: "memory");
        } else {
            XB_SPIN(xb_ld(&bar[XB_XGEN(b.x)]) == gen, bar);
            __builtin_amdgcn_fence(__ATOMIC_ACQUIRE, "agent");
            asm volatile("s_waitcnt vmcnt(0)" ::: "memory");
        }
    }
    __syncthreads();
}

typedef unsigned short bf16;
typedef unsigned v4u __attribute__((ext_vector_type(4)));
typedef unsigned v2u __attribute__((ext_vector_type(2)));
typedef float f32x4 __attribute__((ext_vector_type(4)));
typedef float f32x2 __attribute__((ext_vector_type(2)));
typedef float f32x16 __attribute__((ext_vector_type(16)));
typedef short bf16x8 __attribute__((ext_vector_type(8)));
typedef short s16x4 __attribute__((ext_vector_type(4)));

constexpr int D = 1024, NBATCH = 16, SEQ = 2048, CTXL = 256, TPB = CTXL + SEQ, NLAYER = 2;
constexpr int NBG = 8, NGRP = NBATCH / NBG, GT = NBG * TPB, GTILES = GT / 256;
constexpr int NIN = 10240, NEXP = 16, NWAVES = 8, NTHREADS = NWAVES * 64;
constexpr float EPS = 1e-6f;
constexpr float QSCALE = 0.125f * 1.4426950408889634f;
constexpr size_t MiB = 1u << 20;
constexpr size_t WS_CTL = 0, CTL_ZERO_BYTES = 1 * MiB;
constexpr size_t WS_MOD = 1 * MiB;
constexpr size_t WS_ROPE = 2 * MiB;
constexpr size_t WS_MISC = 2 * MiB + 512 * 1024;
constexpr size_t WS_ROUTE = 3 * MiB;
constexpr size_t WS_XC = 4 * MiB;
constexpr size_t WS_WIN = 20 * MiB;
constexpr size_t WS_WAR = 40 * MiB;
constexpr size_t WS_WO = 44 * MiB;
constexpr size_t WS_WUP = 46 * MiB;
constexpr size_t WS_WDN = 110 * MiB;
constexpr size_t WS_PROJ = 142 * MiB;
constexpr size_t SEG_ELEMS = (size_t)GT * 1024;
constexpr size_t WS_AR = 502 * MiB;
constexpr size_t WS_OB = 574 * MiB;
constexpr size_t WS_HN = 610 * MiB;
constexpr size_t WS_END = 646 * MiB;
constexpr int MAXSLOT = 2 * GT + NEXP * 256;
constexpr size_t WS_H2S = 142 * MiB, WS_HID = 222 * MiB, WS_YE = 302 * MiB;
constexpr size_t WS_LIST = WS_H2S + 40 * MiB;
constexpr int GIDX_OFF = 131072, GIDX_UNITS = 8, MOECN_OFF = GIDX_OFF + GIDX_UNITS * 1024, MOEEX_OFF = MOECN_OFF + 64;
constexpr size_t WS_MIX = WS_PROJ;
constexpr size_t WS_DUMMY = 382 * MiB;
static_assert(WS_YE + (size_t)MAXSLOT * 2048 <= WS_AR && WS_PROJ + 10 * SEG_ELEMS * 2 <= WS_AR && WS_AR + (size_t)GT * 4096 <= WS_OB && WS_OB + SEG_ELEMS * 2 <= WS_HN && WS_HN + SEG_ELEMS * 2 <= WS_END, "ws map");
constexpr int RT_E = 0, RT_P = GT * 8, RT_W = 2 * GT * 8, RT_S = 3 * GT * 8;
#ifndef PROBE_CLASS
#define PROBE_CLASS 0
#endif
constexpr int CW_FILL = 36864;
constexpr int CW_PROBE = 32768;
constexpr int CW_BAR = 4096;
constexpr int CW_QUEUE = 16384;
constexpr int CW_SCAN = 18432;
constexpr int CW_CNT = 20480;
constexpr int RING_BYTES = 131072, LDSCTL_OFF = 147456, MISC_OFF = LDSCTL_OFF + 320, TILE_OFF = LDSCTL_OFF + 1024, LDS_BYTES = 149504;

#define RLX_AGENT __ATOMIC_RELAXED, __HIP_MEMORY_SCOPE_AGENT
__device__ __forceinline__ unsigned f2bf(float f) { unsigned u = __builtin_bit_cast(unsigned, f); return (u + 0x7fffu + ((u >> 16) & 1u)) >> 16; }
typedef __bf16 bf16x2_t __attribute__((ext_vector_type(2)));
__device__ __forceinline__ unsigned pk2(float lo, float hi) { f32x2 v = {lo, hi}; bf16x2_t b = __builtin_convertvector(v, bf16x2_t); return __builtin_bit_cast(unsigned, b); }
__device__ __forceinline__ float bf2f(unsigned short b) { return __builtin_bit_cast(float, (unsigned)b << 16); }
__device__ __forceinline__ float bflo(unsigned w) { return __builtin_bit_cast(float, w << 16); }
__device__ __forceinline__ float bfhi(unsigned w) { return __builtin_bit_cast(float, w & 0xffff0000u); }
__device__ __forceinline__ float sigmoidf_(float z) { return __builtin_amdgcn_rcpf(1.0f + __expf(-z)); }
__device__ __forceinline__ float wave_sum(float v) {
#pragma unroll
    for (int o = 1; o < 64; o <<= 1) v += __shfl_xor(v, o);
    return v;
}

__device__ __forceinline__ int ldg_i(const int* p) { return (int)__hip_atomic_load((const unsigned*)p, RLX_AGENT); }
__device__ __forceinline__ float ldg_f(const float* p) { return __builtin_bit_cast(float, __hip_atomic_load((const unsigned*)p, RLX_AGENT)); }

struct Args { const float* in[25]; float* out; unsigned char* ws; int ph_lo, ph_hi; };

#ifndef WGM_
#define WGM_ 4
#endif
struct DenseOrder {
    static constexpr bool GATHER = false;
    int mode, nM, nN, nwg, G, c, extra;
    __device__ void init(int mode_, int nN_, int G_, int c_) { mode = mode_; nM = (mode == 0) ? GTILES : NBG * 8; nN = nN_; nwg = nM * nN; G = G_; c = c_; extra = (mode == 2) ? NBG * 20 : 0; }
    __device__ bool next(int i, pg8::Unit& u) const {
        const int L = i * G + c; if (L >= nwg + extra) return false;
        if (L >= nwg) { const int r = L - nwg, bi = r / 20, ci = r % 20, sg = ci >> 2; u.pm = bi * 9; u.pn = ((sg == 0) ? 1 : (sg == 1) ? 2 : (sg + 2)) * 4 + (ci & 3); return true; }
        int wgid = L; { const int q = nwg / 8, r = nwg % 8, xcd = wgid % 8, off = wgid / 8; wgid = (xcd < r ? xcd * (q + 1) : r * (q + 1) + (xcd - r) * q) + off; }
        const int nig = WGM_ * nN, gid = wgid / nig, fm = gid * WGM_, gsz = (nM - fm) < WGM_ ? (nM - fm) : WGM_;
        const int pml = fm + ((wgid % nig) % gsz); u.pn = (wgid % nig) / gsz;
        u.pm = (mode == 0) ? pml : (pml >> 3) * 9 + 1 + (pml & 7);
        return true;
    }
    __device__ __forceinline__ void a_ready(const pg8::Unit&) const {}
    __device__ __forceinline__ void done(const pg8::Unit&) const {}
};
template <int NPN, bool GA = false> struct MoeOrder {
    static constexpr bool GATHER = GA;
    const LAS int* gidx;
    const LAS int* tile_e; int nunits, G, c;
    __device__ void init(const LAS int* te, int nt, int G_, int c_, const LAS int* gi = nullptr) { tile_e = te; nunits = nt * NPN; G = G_; c = c_; gidx = gi; }
    __device__ __forceinline__ bool next(int i, pg8::Unit& u) const {
        const int L = i * G + c; if (L >= nunits) return false;
        const int tm = L / NPN, pl = L % NPN; u.pm = tm; u.pn = __builtin_amdgcn_readfirstlane(tile_e[tm]) * NPN + pl; return true;
    }
    __device__ __forceinline__ void a_ready(const pg8::Unit&) const {}
    __device__ __forceinline__ void done(const pg8::Unit&) const {}
};

struct EpiInProj {
    static constexpr bool PERM = true, AFTER_DRAIN = false, HAS_MID = false;
    bf16* proj; const float* ropec; const float* ropes; const float* lb; bool lbzero;
    __device__ __forceinline__ void operator()(const pg8::f32x4 (&acc)[2][2][4][2], const pg8::Unit& u, int wr, int wc, int fr_, int fq_) const {
        int fr = fr_, fq = fq_; asm volatile("" : "+v"(fr), "+v"(fq));
        const int seg = u.pn >> 2, tb = u.pm % 9; const bool lat = tb != 0;
        bf16* base = proj + (size_t)seg * SEG_ELEMS;
        const int colb = (u.pn & 3) * 256 + wc * 32 + 8 * fq;
        f32x4 lbv[2][2];
#pragma unroll
        for (int bj = 0; bj < 2; ++bj) { lbv[bj][0] = (f32x4){0.f, 0.f, 0.f, 0.f}; lbv[bj][1] = lbv[bj][0]; if ((seg == 4 || seg == 5) && !lbzero) { lbv[bj][0] = *(const f32x4*)(lb + colb + bj * 128); lbv[bj][1] = *(const f32x4*)(lb + colb + bj * 128 + 4); } }
#pragma unroll
        for (int ai = 0; ai < 2; ++ai)
#pragma unroll
          for (int mp = 0; mp < 4; mp += 2) {
            f32x4 csv[2], snv[2];
#pragma unroll
            for (int mm = 0; mm < 2; ++mm) { csv[mm] = (f32x4){1.f, 1.f, 1.f, 1.f}; snv[mm] = (f32x4){0.f, 0.f, 0.f, 0.f};
                if (seg < 2 && lat) { const int t = (tb - 1) * 256 + ai * 128 + wr * 64 + (mp + mm) * 16 + fr; csv[mm] = *(const f32x4*)(ropec + t * 32 + (wc & 1) * 16 + 4 * fq); snv[mm] = *(const f32x4*)(ropes + t * 32 + (wc & 1) * 16 + 4 * fq); } }
#pragma unroll
            for (int mm = 0; mm < 2; ++mm) { const int m = mp + mm;
                const int rl = ai * 128 + wr * 64 + m * 16 + fr; const size_t row = (size_t)u.pm * 256 + rl;
                const f32x4 cs = csv[mm], sn = snv[mm];
#pragma unroll
                for (int bj = 0; bj < 2; ++bj) {
                    f32x4 v0 = acc[ai][bj][m][0], v1 = acc[ai][bj][m][1];
                    if (seg < 2) {
                        const f32x4 a = v0 * cs - v1 * sn, b = v0 * sn + v1 * cs; v0 = a; v1 = b;
                        if (seg == 0) { v0 = v0 * QSCALE; v1 = v1 * QSCALE; }
                    } else if (seg == 4 || seg == 5) {
                        const f32x4 l0 = lbv[bj][0], l1 = lbv[bj][1];
#pragma unroll
                        for (int j = 0; j < 4; ++j) {
                            if (lbzero) { const float z0 = v0[j], z1 = v1[j]; v0[j] = fminf(z0, 0.f) - __logf(1.0f + __expf(-fabsf(z0))); v1[j] = fminf(z1, 0.f) - __logf(1.0f + __expf(-fabsf(z1))); }
                            else { const float z0 = v0[j], z1 = v1[j]; v0[j] = __logf(l0[j] + (1.0f - l0[j]) * sigmoidf_(z0)); v1[j] = __logf(l1[j] + (1.0f - l1[j]) * sigmoidf_(z1)); }
                        }
                    } else if (seg == 7) {
#pragma unroll
                        for (int j = 0; j < 4; ++j) { v0[j] = v0[j] * sigmoidf_(v0[j]); v1[j] = v1[j] * sigmoidf_(v1[j]); }
                    } else if (seg >= 8) {
#pragma unroll
                        for (int j = 0; j < 4; ++j) { v0[j] = sigmoidf_(v0[j]); v1[j] = sigmoidf_(v1[j]); }
                    }
                    v4u w; w.x = pk2(v0[0], v0[1]); w.y = pk2(v0[2], v0[3]); w.z = pk2(v1[0], v1[1]); w.w = pk2(v1[2], v1[3]);
                    *(v4u*)(base + row * 1024 + colb + bj * 128) = w;
                }
            }
            asm volatile("" ::: "memory");
          }
    }
};
struct EpiMix {
    static constexpr bool PERM = true, AFTER_DRAIN = false, HAS_MID = true;
    const bf16* ga; const bf16* gr; bf16* mix;
    __device__ __forceinline__ void mid(pg8::f32x4 (&acc)[2][2][4][2], const pg8::Unit& u, int wr, int wc, int fr_, int fq_) const {
        int fr = fr_, fq = fq_; asm volatile("" : "+v"(fr), "+v"(fq));
        const int colb = u.pn * 256 + wc * 32 + 8 * fq;
#pragma unroll
        for (int ai = 0; ai < 2; ++ai)
#pragma unroll
            for (int mp = 0; mp < 4; mp += 2) { v4u av[2][2], rv[2][2];
#pragma unroll
                for (int mm = 0; mm < 2; ++mm) { const size_t row = (size_t)u.pm * 256 + ai * 128 + wr * 64 + (mp + mm) * 16 + fr;
#pragma unroll
                    for (int bj = 0; bj < 2; ++bj) { av[mm][bj] = *(const v4u*)(ga + row * 1024 + colb + bj * 128); rv[mm][bj] = *(const v4u*)(gr + row * 1024 + colb + bj * 128); } }
#pragma unroll
                for (int mm = 0; mm < 2; ++mm)
#pragma unroll
                    for (int bj = 0; bj < 2; ++bj) { const v4u a = av[mm][bj], r = rv[mm][bj]; const int m_ = mp + mm;
                        f32x4 q0, q1;
                        q0[0] = bflo(a.x) * __builtin_amdgcn_rcpf(bflo(r.x)); q0[1] = bfhi(a.x) * __builtin_amdgcn_rcpf(bfhi(r.x)); q0[2] = bflo(a.y) * __builtin_amdgcn_rcpf(bflo(r.y)); q0[3] = bfhi(a.y) * __builtin_amdgcn_rcpf(bfhi(r.y));
                        q1[0] = bflo(a.z) * __builtin_amdgcn_rcpf(bflo(r.z)); q1[1] = bfhi(a.z) * __builtin_amdgcn_rcpf(bfhi(r.z)); q1[2] = bflo(a.w) * __builtin_amdgcn_rcpf(bflo(r.w)); q1[3] = bfhi(a.w) * __builtin_amdgcn_rcpf(bfhi(r.w));
                        acc[ai][bj][m_][0] = acc[ai][bj][m_][0] * q0; acc[ai][bj][m_][1] = acc[ai][bj][m_][1] * q1; }
                asm volatile("" ::: "memory"); }
    }
    __device__ __forceinline__ void operator()(const pg8::f32x4 (&acc)[2][2][4][2], const pg8::Unit& u, int wr, int wc, int fr_, int fq_) const {
        int fr = fr_, fq = fq_; asm volatile("" : "+v"(fr), "+v"(fq));
        const int colb = u.pn * 256 + wc * 32 + 8 * fq;
#pragma unroll
        for (int ai = 0; ai < 2; ++ai) { v4u rv[4][2];
#pragma unroll
            for (int m = 0; m < 4; ++m) { const size_t row = (size_t)u.pm * 256 + ai * 128 + wr * 64 + m * 16 + fr;
#pragma unroll
                for (int bj = 0; bj < 2; ++bj) rv[m][bj] = *(const v4u*)(gr + row * 1024 + colb + bj * 128); }
#pragma unroll
            for (int m = 0; m < 4; ++m) { const size_t row = (size_t)u.pm * 256 + ai * 128 + wr * 64 + m * 16 + fr;
#pragma unroll
                for (int bj = 0; bj < 2; ++bj) { const v4u r = rv[m][bj];
                    const f32x4 v0 = acc[ai][bj][m][0], v1 = acc[ai][bj][m][1]; v4u w;
                    w.x = pk2(v0[0] * bflo(r.x), v0[1] * bfhi(r.x)); w.y = pk2(v0[2] * bflo(r.y), v0[3] * bfhi(r.y));
                    w.z = pk2(v1[0] * bflo(r.z), v1[1] * bfhi(r.z)); w.w = pk2(v1[2] * bflo(r.w), v1[3] * bfhi(r.w));
                    *(v4u*)(mix + row * 1024 + colb + bj * 128) = w; } }
            asm volatile("" ::: "memory"); }
    }
};
struct EpiOut {
    static constexpr bool PERM = false, AFTER_DRAIN = false, HAS_MID = false;
    const float* xsrc; float* xdst; const float* csrc; float* cdst; const float* mod; int bg0;
    __device__ __forceinline__ void operator()(const pg8::f32x4 (&acc)[2][2][4][2], const pg8::Unit& u, int wr, int wc, int fr_, int fq_) const {
        int fr = fr_, fq = fq_; asm volatile("" : "+v"(fr), "+v"(fq));
        const int bl = u.pm / 9, tb = u.pm % 9, bgl = bg0 + bl; const bool lat = tb != 0;
        const float* gate = mod + (size_t)(lat ? bgl : 16) * 6144 + 2 * 1024;
        const int colb = u.pn * 256 + wc * 32 + 4 * fq;
        f32x4 gv[2][2];
#pragma unroll
        for (int bj = 0; bj < 2; ++bj)
#pragma unroll
            for (int n = 0; n < 2; ++n) gv[bj][n] = *(const f32x4*)(gate + colb + bj * 128 + n * 16);
#pragma unroll
        for (int ai = 0; ai < 2; ++ai)
#pragma unroll
            for (int mp = 0; mp < 4; mp += 2) { f32x4 xv[2][2][2];
#pragma unroll
                for (int mm = 0; mm < 2; ++mm) { const int rl = ai * 128 + wr * 64 + (mp + mm) * 16 + fr;
                    const size_t xr = lat ? ((size_t)bgl * SEQ + (tb - 1) * 256 + rl) : ((size_t)bgl * CTXL + rl); const float* s = (lat ? xsrc : csrc) + xr * 1024;
#pragma unroll
                    for (int bj = 0; bj < 2; ++bj)
#pragma unroll
                        for (int n = 0; n < 2; ++n) xv[mm][bj][n] = *(const f32x4*)(s + colb + bj * 128 + n * 16); }
#pragma unroll
                for (int mm = 0; mm < 2; ++mm) { const int rl = ai * 128 + wr * 64 + (mp + mm) * 16 + fr;
                    const size_t xr = lat ? ((size_t)bgl * SEQ + (tb - 1) * 256 + rl) : ((size_t)bgl * CTXL + rl); float* d = (lat ? xdst : cdst) + xr * 1024;
#pragma unroll
                    for (int bj = 0; bj < 2; ++bj)
#pragma unroll
                        for (int n = 0; n < 2; ++n) *(f32x4*)(d + colb + bj * 128 + n * 16) = xv[mm][bj][n] + gv[bj][n] * acc[ai][bj][mp + mm][n]; }
                asm volatile("" ::: "memory"); }
    }
};
struct EpiUp {
    static constexpr bool PERM = false, AFTER_DRAIN = false, HAS_MID = false;
    bf16* hid;
    __device__ __forceinline__ void operator()(const pg8::f32x4 (&acc)[2][2][4][2], const pg8::Unit& u, int wr, int wc, int fr_, int fq_) const {
        int fr = fr_, fq = fq_; asm volatile("" : "+v"(fr), "+v"(fq));
        const int jb = (u.pn & 7) * 128 + wc * 16 + 4 * fq;
#pragma unroll
        for (int ai = 0; ai < 2; ++ai)
#pragma unroll
            for (int m = 0; m < 4; ++m) { const size_t row = (size_t)u.pm * 256 + ai * 128 + wr * 64 + m * 16 + fr;
#pragma unroll
                for (int bj = 0; bj < 2; ++bj) { const f32x4 g = acc[ai][bj][m][0], up = acc[ai][bj][m][1]; f32x4 h;
#pragma unroll
                    for (int j = 0; j < 4; ++j) h[j] = g[j] * sigmoidf_(g[j]) * up[j];
                    v2u w; w.x = pk2(h[0], h[1]); w.y = pk2(h[2], h[3]); *(v2u*)(hid + row * 1024 + jb + bj * 64) = w; } asm volatile("" ::: "memory"); }
    }
};
struct EpiDown {
    static constexpr bool PERM = true, AFTER_DRAIN = false, HAS_MID = false;
    bf16* ye;
    __device__ __forceinline__ void operator()(const pg8::f32x4 (&acc)[2][2][4][2], const pg8::Unit& u, int wr, int wc, int fr_, int fq_) const {
        int fr = fr_, fq = fq_; asm volatile("" : "+v"(fr), "+v"(fq));
        const int colb = (u.pn & 3) * 256 + wc * 32 + 8 * fq;
#pragma unroll
        for (int ai = 0; ai < 2; ++ai)
#pragma unroll
            for (int m = 0; m < 4; ++m) { const size_t row = (size_t)u.pm * 256 + ai * 128 + wr * 64 + m * 16 + fr;
#pragma unroll
                for (int bj = 0; bj < 2; ++bj) { const f32x4 v0 = acc[ai][bj][m][0], v1 = acc[ai][bj][m][1]; v4u w;
                    w.x = pk2(v0[0], v0[1]); w.y = pk2(v0[2], v0[3]); w.z = pk2(v1[0], v1[1]); w.w = pk2(v1[2], v1[3]);
                    *(v4u*)(ye + row * 1024 + colb + bj * 128) = w; } asm volatile("" ::: "memory"); }
    }
};

template <int RMAP> __device__ __forceinline__ void transpose_item(const float* W, int N, bf16* WT, int ldk, int koff, LAS float* scr, int item, int lane) {
    const int nblk = N / 32, kb = item / nblk, nb = item % nblk, k0 = 64 * kb, n0 = 32 * nb;
    { f32x4 wv[8]; const int r_ = lane >> 3, c4 = lane & 7;
#pragma unroll
      for (int i = 0; i < 8; ++i) wv[i] = *(const f32x4*)(W + (size_t)(k0 + 8 * i + r_) * N + n0 + 4 * c4);
#pragma unroll
      for (int i = 0; i < 8; ++i) { LAS float* d_ = scr + (8 * i + r_) * 33 + 4 * c4; d_[0] = wv[i].x; d_[1] = wv[i].y; d_[2] = wv[i].z; d_[3] = wv[i].w; } }
    asm volatile("s_waitcnt lgkmcnt(0)" ::: "memory");
    const int c = lane & 7;
#pragma unroll
    for (int j = 0; j < 4; ++j) { const int nl = (lane >> 3) + 8 * j; const LAS float* s = scr + (8 * c) * 33 + nl; const int n = n0 + nl;
        const int d_ = n & 31; const int row = (RMAP == 0) ? n : (RMAP == 3) ? ((n < 2048) ? ((n & ~31) + 8 * ((d_ >> 2) & 3) + 4 * (d_ >> 4) + (d_ & 3)) : n) : ((n >> 4) * 32 + (n & 15) + (RMAP == 2 ? 16 : 0));
        v4u o; o.x = pk2(s[0 * 33], s[1 * 33]); o.y = pk2(s[2 * 33], s[3 * 33]); o.z = pk2(s[4 * 33], s[5 * 33]); o.w = pk2(s[6 * 33], s[7 * 33]);
        *(v4u*)(WT + (size_t)row * ldk + koff + k0 + 8 * c) = o; }
    asm volatile("s_waitcnt lgkmcnt(0)" ::: "memory");
}
__device__ __forceinline__ void phase_weights(const Args& a, int l, LAS unsigned char* lds, int gw, int ngw, int wave, int lane) {
    LAS float* scr = (LAS float*)(lds + wave * 16384);
    unsigned char* ws = a.ws;
    constexpr int I_IN = 16 * (NIN / 32), I_SQ = 16 * 32;
    constexpr int NITEMS = I_IN + 3 * I_SQ + NEXP * 3 * I_SQ;
    for (int it = gw; it < NITEMS; it += ngw) {
        int r = it;
        if (r < I_IN) { transpose_item<3>(a.in[8] + (size_t)l * 1024 * NIN, NIN, (bf16*)(ws + WS_WIN), 1024, 0, scr, r, lane); continue; } r -= I_IN;
        if (r < I_SQ) { transpose_item<0>(a.in[16] + (size_t)l * 1048576, 1024, (bf16*)(ws + WS_WAR), 2048, 0, scr, r, lane); continue; } r -= I_SQ;
        if (r < I_SQ) { transpose_item<0>(a.in[17] + (size_t)l * 1048576, 1024, (bf16*)(ws + WS_WAR), 2048, 1024, scr, r, lane); continue; } r -= I_SQ;
        if (r < I_SQ) { transpose_item<0>(a.in[18] + (size_t)l * 1048576, 1024, (bf16*)(ws + WS_WO), 1024, 0, scr, r, lane); continue; } r -= I_SQ;
        const int e = r / (3 * I_SQ), w = (r / I_SQ) % 3, ii = r % I_SQ; const size_t eo = ((size_t)l * NEXP + e) * 1048576;
        if (w == 0) transpose_item<1>(a.in[21] + eo, 1024, (bf16*)(ws + WS_WUP) + (size_t)e * 2048 * 1024, 1024, 0, scr, ii, lane);
        else if (w == 1) transpose_item<2>(a.in[22] + eo, 1024, (bf16*)(ws + WS_WUP) + (size_t)e * 2048 * 1024, 1024, 0, scr, ii, lane);
        else transpose_item<0>(a.in[23] + eo, 1024, (bf16*)(ws + WS_WDN) + (size_t)e * 1024 * 1024, 1024, 0, scr, ii, lane);
    }
}
__device__ __forceinline__ void phase_prologue(const Args& a, LAS unsigned char* lds, int tid, int G) {
    unsigned char* ws = a.ws; float* MOD = (float*)(ws + WS_MOD);
    LAS float* sc = (LAS float*)lds;
    LAS float* red = (LAS float*)(lds + 1024 * 20 * 4);
    { float cv[34];
#pragma unroll
      for (int q = 0; q < 34; ++q) { const int i = tid + NTHREADS * q, bi = i >> 10, k = i & 1023; cv[q] = (bi < 16) ? a.in[1][bi * 1024 + k] : a.in[3][k]; }
#pragma unroll
      for (int q = 0; q < 34; ++q) { const int i = tid + NTHREADS * q, bi = i >> 10, k = i & 1023; sc[k * 20 + bi] = cv[q] * sigmoidf_(cv[q]); } }
    __syncthreads();
    const int j = tid & 63, ks = tid >> 6;
    for (int u = blockIdx.x; u < 2 * 96; u += G) {
        const int l = u / 96, col0 = (u % 96) * 64; const float* wm = a.in[4] + (size_t)l * 1024 * 6144 + col0 + j;
        float acc[17];
#pragma unroll
        for (int b = 0; b < 17; ++b) acc[b] = 0.f;
        for (int k0 = ks * 128; k0 < ks * 128 + 128; k0 += 16) { float w[16];
#pragma unroll
            for (int kk = 0; kk < 16; ++kk) w[kk] = wm[(size_t)(k0 + kk) * 6144];
#pragma unroll
            for (int kk = 0; kk < 16; ++kk)
#pragma unroll
                for (int b = 0; b < 17; ++b) acc[b] += sc[(k0 + kk) * 20 + b] * w[kk]; }
#pragma unroll
        for (int b = 0; b < 17; ++b) red[(ks * 17 + b) * 64 + j] = acc[b];
        __syncthreads();
        for (int b = ks; b < 17; b += 8) { float s = 0.f;
#pragma unroll
            for (int q = 0; q < 8; ++q) s += red[(q * 17 + b) * 64 + j];
            MOD[((size_t)l * 17 + b) * 6144 + col0 + j] = s + a.in[5][l * 6144 + col0 + j]; }
        __syncthreads();
    }
    const int gt = blockIdx.x * NTHREADS + tid, ngt = G * NTHREADS;
    float* rc = (float*)(ws + WS_ROPE); float* rs = rc + 2048 * 32;
    for (int i = gt; i < 2048 * 32; i += ngt) { const int t = i >> 5, f = i & 31; const float pos = (f < 16) ? (float)(t >> 6) : (float)(t & 63);
        const float inv = powf(10000.0f, -(float)(f & 15) / 16.0f); const float ang = pos * inv; rc[i] = cosf(ang); rs[i] = sinf(ang); }
    float* misc = (float*)(ws + WS_MISC);
    if (gt < 2) { const int l = gt; float s1 = 0.f, s2 = 0.f;
        for (int i = 0; i < 64; ++i) { s1 += a.in[9][l * 64 + i] * a.in[10][l * 64 + i]; s2 += a.in[11][l * 64 + i] * a.in[12][l * 64 + i]; }
        misc[l] = expf(s1) - expf(s2) + (0.8f - 0.6f * expf(-0.3f * (float)l)); }
    for (int i = gt; i < 1024; i += ngt) { const float a0 = a.in[14][i], a1 = a.in[14][1024 + i]; misc[256 + i] = 0.f; misc[256 + 1024 + i] = 1.0f / (1.0f + expf(a0 - a1)); }
}

struct RowRef { const float* src; float* dst; int bidx; bool lat; };
__device__ __forceinline__ RowRef row_ref(const Args& a, int l, int g, int row) {
    const int bl = row / TPB, pos = row % TPB, bgl = g * NBG + bl; RowRef r; r.lat = pos >= CTXL;
    if (r.lat) { const size_t xr = (size_t)bgl * SEQ + (pos - CTXL); r.src = ((l == 0) ? a.in[0] : a.out) + xr * 1024; r.dst = a.out + xr * 1024; r.bidx = bgl; }
    else { const size_t xr = (size_t)bgl * CTXL + pos; float* xc = (float*)(a.ws + WS_XC); r.src = ((l == 0) ? a.in[2] : xc) + xr * 1024; r.dst = xc + xr * 1024; r.bidx = 16; }
    return r;
}
__device__ __forceinline__ void norm1_rows(const Args& a, int l, int g, bf16* H, int gw, int rend, int ngw, int lane) {
    const float* MOD = (const float*)(a.ws + WS_MOD) + (size_t)l * 17 * 6144; const float* g1 = a.in[6] + l * 1024;
    f32x4 gg[4];
#pragma unroll
    for (int j = 0; j < 4; ++j) gg[j] = *(const f32x4*)(g1 + (64 * j + lane) * 4);
    f32x4 vn[4];
    if (gw < rend) { const RowRef r0 = row_ref(a, l, g, gw); const f32x4* xr = (const f32x4*)r0.src + lane;
#pragma unroll
        for (int j = 0; j < 4; ++j) vn[j] = xr[64 * j]; }
    for (int row = gw; row < rend; row += ngw) {
        const RowRef rr = row_ref(a, l, g, row);
        const float* sh = MOD + (size_t)rr.bidx * 6144; const float* scl = sh + 1024;
        f32x4 ss[4], hh[4];
#pragma unroll
        for (int j = 0; j < 4; ++j) { const int c = (64 * j + lane) * 4; ss[j] = *(const f32x4*)(scl + c); hh[j] = *(const f32x4*)(sh + c); }
        f32x4 v[4]; float s = 0.f;
#pragma unroll
        for (int j = 0; j < 4; ++j) v[j] = vn[j];
        asm volatile("" ::: "memory");
        if (row + ngw < rend) { const RowRef rn = row_ref(a, l, g, row + ngw); const f32x4* xr = (const f32x4*)rn.src + lane;
#pragma unroll
            for (int j = 0; j < 4; ++j) vn[j] = xr[64 * j]; }
#pragma unroll
        for (int j = 0; j < 4; ++j) s += (v[j].x * v[j].x + v[j].y * v[j].y) + (v[j].z * v[j].z + v[j].w * v[j].w);
        const float rstd = rsqrtf(wave_sum(s) * (1.f / D) + EPS);
        v2u* o = (v2u*)(H + (size_t)row * 1024) + lane;
#pragma unroll
        for (int j = 0; j < 4; ++j) { const f32x4 y = v[j] * rstd * gg[j] * (ss[j] + 1.0f) + hh[j]; v2u w; w.x = pk2(y.x, y.y); w.y = pk2(y.z, y.w); o[64 * j] = w; }
    }
}
__device__ __forceinline__ void phase_norm1(const Args& a, int l, int g, int gw, int ngw, int lane) { norm1_rows(a, l, g, (bf16*)(a.ws + WS_AR), gw, GT, ngw, lane); }
constexpr int FILL_ROWS = 64, FILL_UNITS = GT / FILL_ROWS;
__device__ __forceinline__ bool fill_norm1(const Args& a, int lf, int gf, volatile LAS unsigned* misc, int tid, int wave, int lane) {
    unsigned* ctr = (unsigned*)(a.ws + WS_CTL) + CW_FILL + 64 * (lf * NGRP + gf);
    for (;;) {
        __syncthreads();
        if (tid == 0) misc[1] = __hip_atomic_fetch_add(ctr, 1u, RLX_AGENT);
        __syncthreads();
        const int u = __builtin_amdgcn_readfirstlane((int)misc[1]);
        if (u >= FILL_UNITS) return true;
        norm1_rows(a, lf, gf, (bf16*)(a.ws + WS_HN), FILL_ROWS * u + wave, FILL_ROWS * u + FILL_ROWS, NWAVES, lane);
    }
}
__device__ __forceinline__ void rprep_range(unsigned char* ws_, const float* grec_in, int l, int gw, int nrows, int ngw, int lane) {
    bf16* AR = (bf16*)(ws_ + WS_AR); const bf16* OB = (const bf16*)(ws_ + WS_OB); const bf16* SRG = (const bf16*)(ws_ + WS_PROJ) + 7 * SEG_ELEMS; const float* grec = grec_in + l * 128; const int rep = 0;
    v4u fn[2], bn[2], sn[2];
#define RP_ROW(i) ((l == NLAYER - 1) ? ((i) / SEQ) * TPB + CTXL + ((i) % SEQ) : (i))
#define RP_LOAD(i) do { const int r_ = RP_ROW(i); _Pragma("unroll") for (int j = 0; j < 2; ++j) { const int c = j * 512 + lane * 8; fn[j] = *(const v4u*)(AR + (size_t)r_ * 2048 + 1024 + c); bn[j] = *(const v4u*)(OB + (size_t)r_ * 1024 + c); sn[j] = *(const v4u*)(SRG + (size_t)r_ * 1024 + c); } } while (0)
    if (gw < nrows) RP_LOAD(gw);
    for (int i = gw; i < nrows; i += ngw) {
        const int row = RP_ROW(i);
        v4u fc[2], bc[2], sc_[2];
#pragma unroll
        for (int j = 0; j < 2; ++j) { fc[j] = fn[j]; bc[j] = bn[j]; sc_[j] = sn[j]; }
        if (i + ngw < nrows) RP_LOAD(i + ngw);
#pragma unroll
        for (int j = 0; j < 2; ++j) { const int c = j * 512 + lane * 8;
            const v4u f = fc[j], b = bc[j], sg = sc_[j];
            float v[8]; v[0] = bflo(f.x) + bflo(b.x); v[1] = bfhi(f.x) + bfhi(b.x); v[2] = bflo(f.y) + bflo(b.y); v[3] = bfhi(f.y) + bfhi(b.y);
            v[4] = bflo(f.z) + bflo(b.z); v[5] = bfhi(f.z) + bfhi(b.z); v[6] = bflo(f.w) + bflo(b.w); v[7] = bfhi(f.w) + bfhi(b.w);
            float s = 0.f;
#pragma unroll
            for (int q = 0; q < 8; ++q) s += v[q] * v[q];
            s += __shfl_xor(s, 1); s += __shfl_xor(s, 2); s += __shfl_xor(s, 4); s += __shfl_xor(s, 8);
            const float rstd = rsqrtf(s * (1.f / 128.f) + EPS);
            const f32x4 g0 = *(const f32x4*)(grec + (c & 127)), g1 = *(const f32x4*)(grec + (c & 127) + 4);
            v4u w; w.x = pk2(v[0] * rstd * g0.x * bflo(sg.x), v[1] * rstd * g0.y * bfhi(sg.x)); w.y = pk2(v[2] * rstd * g0.z * bflo(sg.y), v[3] * rstd * g0.w * bfhi(sg.y));
            w.z = pk2(v[4] * rstd * g1.x * bflo(sg.z), v[5] * rstd * g1.y * bfhi(sg.z)); w.w = pk2(v[6] * rstd * g1.z * bflo(sg.w), v[7] * rstd * g1.w * bfhi(sg.w));
            *(v4u*)((rep ? (bf16*)(ws_ + WS_PROJ) : AR) + (size_t)row * 2048 + 1024 + c) = w; }
    }
#undef RP_LOAD
#undef RP_ROW
}
__device__ __forceinline__ int moe_row(int l, int i) { return (l == NLAYER - 1) ? (i / SEQ) * TPB + CTXL + (i % SEQ) : i; }
__device__ __forceinline__ int moe_nrows(int l) { return (l == NLAYER - 1) ? NBG * SEQ : GT; }
__device__ __forceinline__ void h2_load(const RowRef& rr, int lane, f32x4 (&v)[4]) {
    const f32x4* xd = (const f32x4*)rr.dst + lane;
#pragma unroll
    for (int j = 0; j < 4; ++j) v[j] = xd[64 * j];
}
struct H2Par { f32x4 ss[4], hh[4]; };
__device__ __forceinline__ void h2_params(const Args& a, int l, int bidx, int lane, H2Par& p) {
    const float* MOD = (const float*)(a.ws + WS_MOD) + (size_t)l * 17 * 6144 + (size_t)bidx * 6144;
#pragma unroll
    for (int j = 0; j < 4; ++j) { const int c = (64 * j + lane) * 4; p.ss[j] = *(const f32x4*)(MOD + 4 * 1024 + c); p.hh[j] = *(const f32x4*)(MOD + 3 * 1024 + c); }
}
__device__ __forceinline__ void h2_finish(const f32x4 (&gg)[4], const H2Par& p, f32x4 (&v)[4]) {
    float s = 0.f;
#pragma unroll
    for (int j = 0; j < 4; ++j) s += (v[j].x * v[j].x + v[j].y * v[j].y) + (v[j].z * v[j].z + v[j].w * v[j].w);
    const float rstd = rsqrtf(wave_sum(s) * (1.f / D) + EPS);
#pragma unroll
    for (int j = 0; j < 4; ++j) v[j] = v[j] * rstd * gg[j] * (p.ss[j] + 1.0f) + p.hh[j];
}
__device__ __forceinline__ void phase_route(const Args& a, int l, int g, LAS unsigned char* lds, int tid, int gw, int ngw, int lane, int rep = 0) {
    LAS float* wrt = (LAS float*)lds;
    { f32x4 wv[8];
#pragma unroll
      for (int k = 0; k < 8; ++k) wv[k] = *(const f32x4*)(a.in[19] + 4 * (tid + NTHREADS * k));
#pragma unroll
      for (int k = 0; k < 8; ++k) { const int i4 = tid + NTHREADS * k, c = i4 >> 2, e0 = 4 * (i4 & 3); wrt[(e0 + 0) * 1024 + c] = wv[k].x; wrt[(e0 + 1) * 1024 + c] = wv[k].y; wrt[(e0 + 2) * 1024 + c] = wv[k].z; wrt[(e0 + 3) * 1024 + c] = wv[k].w; } }
    __syncthreads();
    unsigned* cnt = (unsigned*)(a.ws + WS_CTL) + CW_CNT + (l * NGRP + g + 4 * rep) * 16 * 64;
    const size_t dmy = rep ? (WS_DUMMY - WS_ROUTE) : 0;
    int* rte = (int*)(a.ws + WS_ROUTE + dmy + RT_E); int* rtp = (int*)(a.ws + WS_ROUTE + dmy + RT_P); float* rtw = (float*)(a.ws + WS_ROUTE + dmy + RT_W);
    bf16* h2d = (bf16*)(a.ws + (rep ? WS_DUMMY : WS_H2S)); int* list = (int*)(a.ws + WS_LIST + dmy);
    const int nrows = moe_nrows(l);
    f32x4 vn[2][4], gg2[4];
#pragma unroll
    for (int j = 0; j < 4; ++j) gg2[j] = *(const f32x4*)(a.in[7] + l * 1024 + (64 * j + lane) * 4);
    int cntv = 0, rord = 0, rec_e1 = 0, rec_e2 = 0, rec_l1 = 0, rec_l2 = 0, rec_i = 0; float rec_w1 = 0.f, rec_w2 = 0.f;
#define RT_IDX(u, i_) (((i_) + (u) * ngw < nrows) ? (i_) + (u) * ngw : (i_))
    if (gw < nrows) {
#pragma unroll
        for (int u = 0; u < 2; ++u) h2_load(row_ref(a, l, g, moe_row(l, RT_IDX(u, gw))), lane, vn[u]); }
    for (int i = gw; i < nrows; i += 2 * ngw) {
        H2Par hp[2]; f32x4 v[2][4]; int ii[2];
#pragma unroll
        for (int u = 0; u < 2; ++u) { ii[u] = RT_IDX(u, i); const RowRef rr = row_ref(a, l, g, moe_row(l, ii[u])); h2_params(a, l, rr.bidx, lane, hp[u]);
#pragma unroll
            for (int j = 0; j < 4; ++j) v[u][j] = vn[u][j]; }
        asm volatile("" ::: "memory");
        if (i + 2 * ngw < nrows) {
#pragma unroll
            for (int u = 0; u < 2; ++u) h2_load(row_ref(a, l, g, moe_row(l, RT_IDX(u, i + 2 * ngw))), lane, vn[u]); }
        { float s[2];
#pragma unroll
          for (int u = 0; u < 2; ++u) { s[u] = 0.f;
#pragma unroll
              for (int j = 0; j < 4; ++j) s[u] += (v[u][j].x * v[u][j].x + v[u][j].y * v[u][j].y) + (v[u][j].z * v[u][j].z + v[u][j].w * v[u][j].w); }
#pragma unroll
          for (int o = 1; o < 64; o <<= 1) {
#pragma unroll
              for (int u = 0; u < 2; ++u) s[u] += __shfl_xor(s[u], o); }
#pragma unroll
          for (int u = 0; u < 2; ++u) { const float rstd = rsqrtf(s[u] * (1.f / D) + EPS);
#pragma unroll
              for (int j = 0; j < 4; ++j) v[u][j] = v[u][j] * rstd * gg2[j] * (hp[u].ss[j] + 1.0f) + hp[u].hh[j]; } }
#pragma unroll
        for (int u = 0; u < 2; ++u) { v2u* o = (v2u*)(h2d + (size_t)ii[u] * 1024) + lane;
#pragma unroll
            for (int j = 0; j < 4; ++j) { v2u w; w.x = pk2(v[u][j].x, v[u][j].y); w.y = pk2(v[u][j].z, v[u][j].w); o[64 * j] = w; } }
        float pe[2][16];
        f32x2 vp[4][4];
#pragma unroll
        for (int j = 0; j < 4; ++j) { vp[j][0] = (f32x2){v[0][j].x, v[1][j].x}; vp[j][1] = (f32x2){v[0][j].y, v[1][j].y}; vp[j][2] = (f32x2){v[0][j].z, v[1][j].z}; vp[j][3] = (f32x2){v[0][j].w, v[1][j].w}; }
#pragma unroll
        for (int e = 0; e < 16; ++e) { f32x2 ac = {0.f, 0.f};
#pragma unroll
            for (int j = 0; j < 4; ++j) { const f32x4 w = *(const LAS f32x4*)(wrt + e * 1024 + (64 * j + lane) * 4);
                ac = __builtin_elementwise_fma(vp[j][0], (f32x2){w.x, w.x}, ac); ac = __builtin_elementwise_fma(vp[j][1], (f32x2){w.y, w.y}, ac);
                ac = __builtin_elementwise_fma(vp[j][2], (f32x2){w.z, w.z}, ac); ac = __builtin_elementwise_fma(vp[j][3], (f32x2){w.w, w.w}, ac); }
            pe[0][e] = ac.x; pe[1][e] = ac.y; if ((e & 3) == 3) asm volatile("" ::: "memory"); }
        float r8[2][8], r4[2][4], r2[2][2], r1[2];
#pragma unroll
        for (int k = 0; k < 8; ++k)
#pragma unroll
            for (int u = 0; u < 2; ++u) { const bool hi_ = (lane & 32) != 0; const float keep = hi_ ? pe[u][8 + k] : pe[u][k], send = hi_ ? pe[u][k] : pe[u][8 + k]; r8[u][k] = keep + __shfl_xor(send, 32); }
#pragma unroll
        for (int k = 0; k < 4; ++k)
#pragma unroll
            for (int u = 0; u < 2; ++u) { const bool hi_ = (lane & 16) != 0; const float keep = hi_ ? r8[u][4 + k] : r8[u][k], send = hi_ ? r8[u][k] : r8[u][4 + k]; r4[u][k] = keep + __shfl_xor(send, 16); }
#pragma unroll
        for (int k = 0; k < 2; ++k)
#pragma unroll
            for (int u = 0; u < 2; ++u) { const bool hi_ = (lane & 8) != 0; const float keep = hi_ ? r4[u][2 + k] : r4[u][k], send = hi_ ? r4[u][k] : r4[u][2 + k]; r2[u][k] = keep + __shfl_xor(send, 8); }
#pragma unroll
        for (int u = 0; u < 2; ++u) { const bool hi_ = (lane & 4) != 0; const float keep = hi_ ? r2[u][1] : r2[u][0], send = hi_ ? r2[u][0] : r2[u][1]; r1[u] = keep + __shfl_xor(send, 4); }
#pragma unroll
        for (int u = 0; u < 2; ++u) r1[u] += __shfl_xor(r1[u], 2);
#pragma unroll
        for (int u = 0; u < 2; ++u) r1[u] += __shfl_xor(r1[u], 1);
        int e1v[2], e2v[2]; float w1v[2], w2v[2];
#pragma unroll
        for (int u = 0; u < 2; ++u) {
            const float sg_ = sigmoidf_(r1[u]);
            float sc[16];
#pragma unroll
            for (int e = 0; e < 16; ++e) sc[e] = __builtin_bit_cast(float, __builtin_amdgcn_readlane(__builtin_bit_cast(int, sg_), 4 * e));
            float bs[16];
#pragma unroll
            for (int e = 0; e < 16; ++e) bs[e] = sc[e] + a.in[20][e];
            int grp = 0; float best = -1e30f;
#pragma unroll
            for (int q = 0; q < 4; ++q) { float t1 = -1e30f, t2 = -1e30f;
#pragma unroll
                for (int e = 0; e < 4; ++e) { const float x = bs[4 * q + e]; if (x > t1) { t2 = t1; t1 = x; } else if (x > t2) t2 = x; }
                const float gs = t1 + t2; if (gs > best) { best = gs; grp = q; } }
            float ib[4], is[4];
#pragma unroll
            for (int e = 0; e < 4; ++e) { ib[e] = (grp == 0) ? bs[e] : (grp == 1) ? bs[4 + e] : (grp == 2) ? bs[8 + e] : bs[12 + e]; is[e] = (grp == 0) ? sc[e] : (grp == 1) ? sc[4 + e] : (grp == 2) ? sc[8 + e] : sc[12 + e]; }
            int i1 = 0; float b1 = ib[0], s1 = is[0];
#pragma unroll
            for (int e = 1; e < 4; ++e) if (ib[e] > b1) { b1 = ib[e]; i1 = e; s1 = is[e]; }
            int i2 = -1; float b2 = -1e30f, s2 = 0.f;
#pragma unroll
            for (int e = 0; e < 4; ++e) if (e != i1 && ib[e] > b2) { b2 = ib[e]; i2 = e; s2 = is[e]; }
            e1v[u] = grp * 4 + i1; e2v[u] = grp * 4 + i2; const float inv = 1.0f / (s1 + s2); w1v[u] = s1 * inv; w2v[u] = s2 * inv;
        }
#pragma unroll
        for (int u = 0; u < 2; ++u) {
            if (u == 0 || i + ngw < nrows) {
                const int e1 = e1v[u], e2 = e2v[u];
                const int l1 = __shfl(cntv, e1), l2 = __shfl(cntv, e2);
                if (lane == e1 || lane == e2) cntv += 1;
                if (lane == rord) { rec_e1 = e1; rec_e2 = e2; rec_l1 = l1; rec_l2 = l2; rec_w1 = w1v[u]; rec_w2 = w2v[u]; rec_i = ii[u]; }
                ++rord;
            }
        }
    }
#undef RT_IDX
    __syncthreads();
    LAS int* cl = (LAS int*)lds;
    const int wv_ = __builtin_amdgcn_readfirstlane(tid >> 6);
    if (lane < 16) cl[wv_ * 16 + lane] = cntv;
    __syncthreads();
    if (wv_ == 0 && lane < 16) { int tot = 0;
#pragma unroll
        for (int w = 0; w < NWAVES; ++w) tot += cl[w * 16 + lane];
        int b0 = 0; if (tot > 0) b0 = (int)__hip_atomic_fetch_add(cnt + lane * 64, (unsigned)tot, RLX_AGENT);
        cl[128 + lane] = b0; }
    __syncthreads();
    int base = 0;
    if (lane < 16) { base = cl[128 + lane];
        for (int w = 0; w < wv_; ++w) base += cl[w * 16 + lane]; }
    const int b1_ = __shfl(base, rec_e1), b2_ = __shfl(base, rec_e2);
    if (lane < rord) { rte[2 * rec_i] = rec_e1; rte[2 * rec_i + 1] = rec_e2; rtp[2 * rec_i] = b1_ + rec_l1; rtp[2 * rec_i + 1] = b2_ + rec_l2; rtw[2 * rec_i] = rec_w1; rtw[2 * rec_i + 1] = rec_w2;
        list[rec_e1 * GT + b1_ + rec_l1] = rec_i; list[rec_e2 * GT + b2_ + rec_l2] = rec_i; }
}
__device__ __forceinline__ int moe_tables(const unsigned char* ws_, int l, int g, LAS unsigned char* lds, int tid) {
    const unsigned* cnt = (const unsigned*)(ws_ + WS_CTL) + CW_CNT + (l * NGRP + g) * 16 * 64;
    LAS int* tl = (LAS int*)(lds + TILE_OFF); LAS int* cn = (LAS int*)(lds + MOECN_OFF); LAS int* ex = (LAS int*)(lds + MOEEX_OFF);
    if (tid < 16) cn[tid] = (int)__hip_atomic_load(cnt + tid * 64, RLX_AGENT);
    __syncthreads();
    int incl = 0, myexp = 0;
#pragma unroll
    for (int e = 0; e < 16; ++e) { const int pc = (cn[e] + 255) & ~255; if (tid == e) ex[e] = incl; incl += pc; if (256 * tid >= incl) myexp = e + 1; }
    if (tid < 256) tl[tid] = (myexp < 16) ? myexp : 0;
    __syncthreads();
    return incl >> 8;
}
__device__ __forceinline__ void phase_combine(const Args& a, int l, int g, int gw, int ngw, int lane, int rep = 0) {
    const int* rte = (const int*)(a.ws + WS_ROUTE + RT_E); const int* rtp = (const int*)(a.ws + WS_ROUTE + RT_P); const float* rtw = (const float*)(a.ws + WS_ROUTE + RT_W); const bf16* YE = (const bf16*)(a.ws + WS_YE);
    const float* MODL = (const float*)(a.ws + WS_MOD) + (size_t)l * 17 * 6144;
    const int nrows = moe_nrows(l);
    int excl; { const unsigned* cnt = (const unsigned*)(a.ws + WS_CTL) + CW_CNT + (l * NGRP + g) * 16 * 64;
        int pc = 0; if (lane < 16) pc = ((int)__hip_atomic_load(cnt + lane * 64, RLX_AGENT) + 255) & ~255;
        int incl = pc;
#pragma unroll
        for (int o = 1; o < 16; o <<= 1) { const int t = __shfl_up(incl, o); if (lane >= o) incl += t; }
        excl = incl - pc; }
#define CB_SLOTS(i_) do { const int e1_ = ldg_i(rte + 2 * (i_)), e2_ = ldg_i(rte + 2 * (i_) + 1), p1_ = ldg_i(rtp + 2 * (i_)), p2_ = ldg_i(rtp + 2 * (i_) + 1); sn1 = __shfl(excl, e1_) + p1_; sn2 = __shfl(excl, e2_) + p2_; } while (0)
    f32x4 xn[4]; int sn1 = 0, sn2 = 0; float wn1 = 0.f, wn2 = 0.f;
    if (gw < nrows) { h2_load(row_ref(a, l, g, moe_row(l, gw)), lane, xn); CB_SLOTS(gw); wn1 = ldg_f(rtw + 2 * gw); wn2 = ldg_f(rtw + 2 * gw + 1); }
    for (int i = gw; i < nrows; i += ngw) {
        const int row = moe_row(l, i); const RowRef rr = row_ref(a, l, g, row);
        const int s1 = sn1, s2 = sn2; const float w1 = wn1, w2 = wn2;
        f32x4 xc[4];
#pragma unroll
        for (int j = 0; j < 4; ++j) xc[j] = xn[j];
        const float* gate = MODL + (size_t)rr.bidx * 6144 + 5 * 1024;
        f32x4* xd = rep ? ((f32x4*)(a.ws + WS_DUMMY) + (size_t)i * 256 + lane) : ((f32x4*)rr.dst + lane); const v2u* y1 = (const v2u*)(YE + (size_t)s1 * 1024) + lane; const v2u* y2 = (const v2u*)(YE + (size_t)s2 * 1024) + lane;
        v2u yp[4], yq[4]; f32x4 gt[4];
#pragma unroll
        for (int j = 0; j < 4; ++j) { yp[j] = y1[64 * j]; yq[j] = y2[64 * j]; gt[j] = *(const f32x4*)(gate + (64 * j + lane) * 4); }
        asm volatile("" ::: "memory");
        if (i + ngw < nrows) { const int in_ = i + ngw; h2_load(row_ref(a, l, g, moe_row(l, in_)), lane, xn); CB_SLOTS(in_); wn1 = ldg_f(rtw + 2 * in_); wn2 = ldg_f(rtw + 2 * in_ + 1); }
        f32x4 v[4]; float s = 0.f;
#pragma unroll
        for (int j = 0; j < 4; ++j) { const f32x4 x = xc[j]; const v2u p = yp[j], q = yq[j]; const f32x4 gg = gt[j];
            f32x4 y; y.x = w1 * bflo(p.x) + w2 * bflo(q.x); y.y = w1 * bfhi(p.x) + w2 * bfhi(q.x); y.z = w1 * bflo(p.y) + w2 * bflo(q.y); y.w = w1 * bfhi(p.y) + w2 * bfhi(q.y);
            v[j] = x + gg * y; s += (v[j].x * v[j].x + v[j].y * v[j].y) + (v[j].z * v[j].z + v[j].w * v[j].w); }
        if (l == NLAYER - 1) { const float rstd = rsqrtf(wave_sum(s) * (1.f / D) + EPS);
#pragma unroll
            for (int j = 0; j < 4; ++j) xd[64 * j] = v[j] * rstd * *(const f32x4*)(a.in[24] + (64 * j + lane) * 4); }
        else {
#pragma unroll
            for (int j = 0; j < 4; ++j) xd[64 * j] = v[j]; }
    }
#undef CB_SLOTS
}

__device__ __forceinline__ unsigned off_b(unsigned row, unsigned ch) { return 256u * row + 16u * (ch ^ (((row & 3u) << 2) | ((row >> 2) & 3u))); }
typedef __attribute__((address_space(3))) const unsigned char* lds_cptr;
__device__ __forceinline__ s16x4 vtr(lds_cptr p) { return __builtin_bit_cast(s16x4, __builtin_amdgcn_ds_read_tr16_b64_v4i16((__attribute__((address_space(3))) s16x4*)p)); }
__device__ __forceinline__ unsigned cvtpk(float lo, float hi) { return pk2(lo, hi); }

__device__ __forceinline__ void scan_unit(unsigned char* ws_, LAS unsigned char* lds, int tid, int bl, int h, int dir) {
    const bf16* P = (const bf16*)(ws_ + WS_PROJ);
    const bf16* RQ = P + 3 * SEG_ELEMS; const bf16* GG = P + (size_t)(4 + dir) * SEG_ELEMS; const bf16* RI = P + 6 * SEG_ELEMS;
    bf16* OUT = dir ? (bf16*)(ws_ + WS_OB) : (bf16*)(ws_ + WS_AR) + 1024; const int ldo = dir ? 1024 : 2048;
    LAS float* F = (LAS float*)lds; LAS float* KK = F + 4096; LAS float* QS = KK + 4096; LAS float* VS = QS + 4096; LAS float* OP = VS + 4096;
    const int e = tid & 127, dq = tid >> 7, sstep = tid >> 4, sch = tid & 15;
    float S[32];
#pragma unroll
    for (int i = 0; i < 32; ++i) S[i] = 0.f;
    const size_t rowbase = (size_t)bl * TPB;
    for (int tb = 0; tb < TPB / 32; ++tb) {
        { const int tau = tb * 32 + sstep; const int pos = dir ? ((tau < CTXL) ? (CTXL - 1 - tau) : (TPB - 1 - (tau - CTXL))) : tau;
          const size_t off = (rowbase + pos) * 1024 + h * 128 + sch * 8;
          const v4u gq = *(const v4u*)(GG + off), qq = *(const v4u*)(RQ + off), vv = *(const v4u*)(RI + off);
          float gv[8] = {bflo(gq.x), bfhi(gq.x), bflo(gq.y), bfhi(gq.y), bflo(gq.z), bfhi(gq.z), bflo(gq.w), bfhi(gq.w)};
          float qv[8] = {bflo(qq.x), bfhi(qq.x), bflo(qq.y), bfhi(qq.y), bflo(qq.z), bfhi(qq.z), bflo(qq.w), bfhi(qq.w)};
          float vv8[8] = {bflo(vv.x), bfhi(vv.x), bflo(vv.y), bfhi(vv.y), bflo(vv.z), bfhi(vv.z), bflo(vv.w), bfhi(vv.w)};
#pragma unroll
          for (int i = 0; i < 8; ++i) { const float f = __expf(gv[i]); F[sstep * 128 + sch * 8 + i] = f; KK[sstep * 128 + sch * 8 + i] = 1.0f - f; QS[sstep * 128 + sch * 8 + i] = qv[i]; VS[sstep * 128 + sch * 8 + i] = vv8[i]; } }
        __syncthreads();
        for (int st = 0; st < 32; ++st) {
            const float v = VS[st * 128 + e]; float acc = 0.f;
            const LAS f32x4* f4 = (const LAS f32x4*)(F + st * 128 + dq * 32); const LAS f32x4* k4 = (const LAS f32x4*)(KK + st * 128 + dq * 32); const LAS f32x4* q4 = (const LAS f32x4*)(QS + st * 128 + dq * 32);
#pragma unroll
            for (int i = 0; i < 8; ++i) { const f32x4 ff = f4[i], kk = k4[i], qq = q4[i];
                S[4 * i + 0] = ff.x * S[4 * i + 0] + kk.x * v; acc += S[4 * i + 0] * qq.x;
                S[4 * i + 1] = ff.y * S[4 * i + 1] + kk.y * v; acc += S[4 * i + 1] * qq.y;
                S[4 * i + 2] = ff.z * S[4 * i + 2] + kk.z * v; acc += S[4 * i + 2] * qq.z;
                S[4 * i + 3] = ff.w * S[4 * i + 3] + kk.w * v; acc += S[4 * i + 3] * qq.w; }
            OP[(dq * 32 + st) * 128 + e] = acc;
        }
        __syncthreads();
#pragma unroll
        for (int j = 0; j < 8; ++j) { const int st = dq + 4 * j; const float o = (OP[(0 * 32 + st) * 128 + e] + OP[(1 * 32 + st) * 128 + e]) + (OP[(2 * 32 + st) * 128 + e] + OP[(3 * 32 + st) * 128 + e]);
            const int tau = tb * 32 + st; const int pos = dir ? ((tau < CTXL) ? (CTXL - 1 - tau) : (TPB - 1 - (tau - CTXL))) : tau;
            OUT[(rowbase + pos) * ldo + h * 128 + e] = (bf16)f2bf(o); }
    }
    __syncthreads();
}

typedef float f32x4s __attribute__((ext_vector_type(4)));
__device__ __forceinline__ void scan_unit_mfma(unsigned char* ws_, LAS unsigned char* lds, int tid, int l, int bl, int h, int dir) {
    const bf16* PJ = (const bf16*)(ws_ + WS_PROJ);
    const bf16* RQ = PJ + 3 * SEG_ELEMS; const bf16* GG = PJ + (size_t)(4 + dir) * SEG_ELEMS; const bf16* RI = PJ + 6 * SEG_ELEMS;
    bf16* OUT = dir ? (bf16*)(ws_ + WS_OB) : (bf16*)(ws_ + WS_AR) + 1024; const int ldo = dir ? 1024 : 2048;
    LAS unsigned char* QT = lds; LAS unsigned char* KT = lds + 16384; LAS unsigned char* KH = lds + 32768; LAS unsigned char* VT = lds + 49152; LAS unsigned char* PL = lds + 65536;
    LAS float* TOT = (LAS float*)(lds + 73728); LAS float* EGM = TOT + 1024; LAS float* EGE = EGM + 128;
    const int lane = tid & 63, wid = __builtin_amdgcn_readfirstlane(tid >> 6), l15 = lane & 15, g4 = lane >> 4;
    const int dp = lane, tg = wid;
    const size_t rowbase = (size_t)bl * TPB; const size_t colo = (size_t)h * 128 + 2 * dp;
    f32x4 S[8];
#pragma unroll
    for (int i = 0; i < 8; ++i) S[i] = (f32x4){0.f, 0.f, 0.f, 0.f};
    unsigned gr_[8], qr_[8], vr_[8];
#define SCAN_POS(tau) (dir ? (((tau) < CTXL) ? (CTXL - 1 - (tau)) : (TPB - 1 - ((tau) - CTXL))) : (tau))
#define SCAN_LOAD(c) do { _Pragma("unroll") for (int i = 0; i < 8; ++i) { const int tau = 64 * (c) + 8 * tg + i; const size_t off = (rowbase + SCAN_POS(tau)) * 1024 + colo; gr_[i] = *(const unsigned*)(GG + off); qr_[i] = *(const unsigned*)(RQ + off); vr_[i] = *(const unsigned*)(RI + off); } } while (0)
    SCAN_LOAD(0);
    for (int c = 0; c < TPB / 64; ++c) {
        const bool need_o = !(l == NLAYER - 1 && c < CTXL / 64);
        float cs0[8], cs1[8]; float run0 = 0.f, run1 = 0.f;
#pragma unroll
        for (int i = 0; i < 8; ++i) { run0 += bflo(gr_[i]); run1 += bfhi(gr_[i]); cs0[i] = run0; cs1[i] = run1; }
        *(LAS f32x2*)(TOT + tg * 128 + 2 * dp) = (f32x2){run0, run1};
        __syncthreads();
        float of0 = 0.f, of1 = 0.f, gm0 = 0.f, gm1 = 0.f, ge0 = 0.f, ge1 = 0.f;
#pragma unroll
        for (int q = 0; q < 8; ++q) { const f32x2 tv = *(const LAS f32x2*)(TOT + q * 128 + 2 * dp); if (q < tg) { of0 += tv.x; of1 += tv.y; } if (q < 4) { gm0 += tv.x; gm1 += tv.y; } ge0 += tv.x; ge1 += tv.y; }
        if (tg == 0) { *(LAS f32x2*)(EGM + 2 * dp) = (f32x2){__expf(gm0), __expf(gm1)}; *(LAS f32x2*)(EGE + 2 * dp) = (f32x2){__expf(ge0), __expf(ge1)}; }
        const float egd0 = __expf(ge0 - gm0), egd1 = __expf(ge1 - gm1);
        unsigned kh0[4], kh1[4], vt0[4], vt1[4];
#pragma unroll
        for (int i = 0; i < 8; i += 2) {
            float a0[2], a1[2];
#pragma unroll
            for (int q = 0; q < 2; ++q) { const int ii = i + q, t = 8 * tg + ii; const float G0 = of0 + cs0[ii], G1 = of1 + cs1[ii];
                const float k0 = 1.0f - __expf(bflo(gr_[ii])), k1 = 1.0f - __expf(bfhi(gr_[ii]));
                const float q0 = bflo(qr_[ii]) * __expf(G0 - gm0), q1 = bfhi(qr_[ii]) * __expf(G1 - gm1);
                const float kt0 = k0 * __expf(gm0 - G0), kt1 = k1 * __expf(gm1 - G1); a0[q] = kt0 * egd0; a1[q] = kt1 * egd1;
                const unsigned so = t * 256 + 16 * ((unsigned)(dp >> 2) ^ (unsigned)(t & 15)) + 4 * (dp & 3);
                *(LAS unsigned*)(QT + so) = pk2(q0, q1); *(LAS unsigned*)(KT + so) = pk2(kt0, kt1); }
            kh0[i >> 1] = pk2(a0[0], a0[1]); kh1[i >> 1] = pk2(a1[0], a1[1]);
            vt0[i >> 1] = (vr_[i] & 0xffffu) | (vr_[i + 1] << 16); vt1[i >> 1] = (vr_[i] >> 16) | (vr_[i + 1] & 0xffff0000u);
        }
        { const unsigned d0_ = 2 * dp, d1_ = 2 * dp + 1; const unsigned o0 = d0_ * 128 + 16 * ((unsigned)tg ^ (d0_ & 7)), o1 = d1_ * 128 + 16 * ((unsigned)tg ^ (d1_ & 7));
          *(LAS v4u*)(KH + o0) = (v4u){kh0[0], kh0[1], kh0[2], kh0[3]}; *(LAS v4u*)(KH + o1) = (v4u){kh1[0], kh1[1], kh1[2], kh1[3]};
          *(LAS v4u*)(VT + o0) = (v4u){vt0[0], vt0[1], vt0[2], vt0[3]}; *(LAS v4u*)(VT + o1) = (v4u){vt1[0], vt1[1], vt1[2], vt1[3]}; }
        __syncthreads();
        if (c + 1 < TPB / 64) SCAN_LOAD(c + 1);
        f32x4 acc[4];
#pragma unroll
        for (int i = 0; i < 4; ++i) acc[i] = (f32x4){0.f, 0.f, 0.f, 0.f};
        if (need_o) {
            const int ti = wid >> 1;
#pragma unroll
            for (int jj = 0; jj < 2; ++jj) { const int sj = 2 * (wid & 1) + jj; f32x4 sc = {0.f, 0.f, 0.f, 0.f};
                if (sj <= ti) { const int ra = 16 * ti + l15, rb = 16 * sj + l15;
#pragma unroll
                    for (int ks = 0; ks < 4; ++ks) { const bf16x8 av = *(const LAS bf16x8*)(QT + ra * 256 + 16 * ((4 * ks + g4) ^ (ra & 15))), bv = *(const LAS bf16x8*)(KT + rb * 256 + 16 * ((4 * ks + g4) ^ (rb & 15)));
                        sc = __builtin_amdgcn_mfma_f32_16x16x32_bf16(av, bv, sc, 0, 0, 0); } }
                const int s = 16 * sj + l15;
#pragma unroll
                for (int r = 0; r < 4; ++r) { const int t = 16 * ti + 4 * g4 + r; const float v = (s <= t) ? sc[r] : 0.f;
                    *(LAS unsigned short*)(PL + t * 128 + 16 * ((s >> 3) ^ (t & 7)) + 2 * (s & 7)) = (unsigned short)f2bf(v); } }
            bf16x8 sb[4];
#pragma unroll
            for (int ks = 0; ks < 4; ++ks) { const f32x4 e0 = *(const LAS f32x4*)(EGM + 32 * ks + 4 * g4), e1 = *(const LAS f32x4*)(EGM + 32 * ks + 16 + 4 * g4); const f32x4 x0 = S[2 * ks] * e0, x1 = S[2 * ks + 1] * e1;
                v4u w; w.x = pk2(x0[0], x0[1]); w.y = pk2(x0[2], x0[3]); w.z = pk2(x1[0], x1[1]); w.w = pk2(x1[2], x1[3]); sb[ks] = __builtin_bit_cast(bf16x8, w); }
#pragma unroll
            for (int i = 0; i < 4; ++i) { const int ra = 16 * i + l15;
#pragma unroll
                for (int ks = 0; ks < 4; ++ks) { const v2u lo = *(const LAS v2u*)(QT + ra * 256 + 16 * ((4 * ks + (g4 >> 1)) ^ (ra & 15)) + 8 * (g4 & 1)), hi = *(const LAS v2u*)(QT + ra * 256 + 16 * ((4 * ks + 2 + (g4 >> 1)) ^ (ra & 15)) + 8 * (g4 & 1));
                    const v4u w = {lo.x, lo.y, hi.x, hi.y}; acc[i] = __builtin_amdgcn_mfma_f32_16x16x32_bf16(__builtin_bit_cast(bf16x8, w), sb[ks], acc[i], 0, 0, 0); } }
        }
        __syncthreads();
        bf16x8 vt[2];
        { const int re = 16 * wid + l15;
#pragma unroll
          for (int ks = 0; ks < 2; ++ks) vt[ks] = *(const LAS bf16x8*)(VT + re * 128 + 16 * ((4 * ks + g4) ^ (re & 7))); }
        if (need_o) {
#pragma unroll
            for (int i = 0; i < 4; ++i) { const int ra = 16 * i + l15;
#pragma unroll
                for (int ks = 0; ks < 2; ++ks) { const bf16x8 pv = *(const LAS bf16x8*)(PL + ra * 128 + 16 * ((4 * ks + g4) ^ (ra & 7))); acc[i] = __builtin_amdgcn_mfma_f32_16x16x32_bf16(pv, vt[ks], acc[i], 0, 0, 0); } }
#pragma unroll
            for (int i = 0; i < 4; ++i)
#pragma unroll
                for (int r = 0; r < 4; ++r) { const int tau = 64 * c + 16 * i + 4 * g4 + r; OUT[(rowbase + SCAN_POS(tau)) * ldo + h * 128 + 16 * wid + l15] = (bf16)f2bf(acc[i][r]); }
        }
#pragma unroll
        for (int db = 0; db < 8; ++db) { const f32x4 eg = *(const LAS f32x4*)(EGE + 16 * db + 4 * g4); S[db] = S[db] * eg; const int rd = 16 * db + l15;
#pragma unroll
            for (int ks = 0; ks < 2; ++ks) { const bf16x8 kv = *(const LAS bf16x8*)(KH + rd * 128 + 16 * ((4 * ks + g4) ^ (rd & 7))); S[db] = __builtin_amdgcn_mfma_f32_16x16x32_bf16(kv, vt[ks], S[db], 0, 0, 0); } }
        __syncthreads();
    }
#undef SCAN_LOAD
#undef SCAN_POS
}

__device__ __forceinline__ void scan_unit_pipe(unsigned char* ws_, LAS unsigned char* lds, int tid, int l, int bl, int h, int dir) {
    const bf16* PJ = (const bf16*)(ws_ + WS_PROJ);
    const bf16* RQ = PJ + 3 * SEG_ELEMS; const bf16* GG = PJ + (size_t)(4 + dir) * SEG_ELEMS; const bf16* RI = PJ + 6 * SEG_ELEMS;
    bf16* OUT = dir ? (bf16*)(ws_ + WS_OB) : (bf16*)(ws_ + WS_AR) + 1024; const int ldo = dir ? 1024 : 2048;
    LAS unsigned char* PL = lds + 131072; LAS float* TOT = (LAS float*)(lds + 139264); LAS float* EG = (LAS float*)(lds + 143360);
    const int lane = tid & 63, wid = __builtin_amdgcn_readfirstlane(tid >> 6), l15 = lane & 15, g4 = lane >> 4;
    const int dp = lane, tg = wid;
    const size_t rowbase = (size_t)bl * TPB; const size_t colo = (size_t)h * 128 + 2 * dp;
    constexpr int NCH = TPB / 64;
    f32x4 S[8];
#pragma unroll
    for (int i = 0; i < 8; ++i) S[i] = (f32x4){0.f, 0.f, 0.f, 0.f};
    unsigned gr_[8], qr_[8], vr_[8], gn_[8];
#define SCAN_POS(tau) (dir ? (((tau) < CTXL) ? (CTXL - 1 - (tau)) : (TPB - 1 - ((tau) - CTXL))) : (tau))
#define SCAN_LOADN(c) do { _Pragma("unroll") for (int i = 0; i < 8; ++i) { const int tau = 64 * (c) + 8 * tg + i; const size_t off = (rowbase + SCAN_POS(tau)) * 1024 + colo; gn_[i] = *(const unsigned*)(GG + off); } } while (0)
#define SCAN_LOADQV(c) do { _Pragma("unroll") for (int i = 0; i < 8; ++i) { const int tau = 64 * (c) + 8 * tg + i; const size_t off = (rowbase + SCAN_POS(tau)) * 1024 + colo; qr_[i] = *(const unsigned*)(RQ + off); vr_[i] = *(const unsigned*)(RI + off); } } while (0)
#define SCAN_LOAD(c) do { _Pragma("unroll") for (int i = 0; i < 8; ++i) { const int tau = 64 * (c) + 8 * tg + i; const size_t off = (rowbase + SCAN_POS(tau)) * 1024 + colo; gr_[i] = *(const unsigned*)(GG + off); qr_[i] = *(const unsigned*)(RQ + off); vr_[i] = *(const unsigned*)(RI + off); } } while (0)
#define SCAN_PREP1() do { float run0 = 0.f, run1 = 0.f; _Pragma("unroll") for (int i = 0; i < 8; ++i) { run0 += bflo(gr_[i]); run1 += bfhi(gr_[i]); } \
        *(LAS f32x2*)(TOT + tg * 128 + 2 * dp) = (f32x2){run0, run1}; } while (0)
#define SCAN_PREP2(so_, egs_) do { LAS unsigned char* QT_ = lds + (so_); LAS unsigned char* KT_ = QT_ + 16384; LAS unsigned char* KH_ = QT_ + 32768; LAS unsigned char* VT_ = QT_ + 49152; \
        float of0 = 0.f, of1 = 0.f, gm0 = 0.f, gm1 = 0.f, ge0 = 0.f, ge1 = 0.f; \
        _Pragma("unroll") for (int q = 0; q < 8; ++q) { const f32x2 tv = *(const LAS f32x2*)(TOT + q * 128 + 2 * dp); if (q < tg) { of0 += tv.x; of1 += tv.y; } if (q < 4) { gm0 += tv.x; gm1 += tv.y; } ge0 += tv.x; ge1 += tv.y; } \
        if (tg == 0) { *(LAS f32x2*)((egs_) + 2 * dp) = (f32x2){__expf(gm0), __expf(gm1)}; *(LAS f32x2*)((egs_) + 128 + 2 * dp) = (f32x2){__expf(ge0), __expf(ge1)}; } \
        const float egd0 = __expf(ge0 - gm0), egd1 = __expf(ge1 - gm1); \
        float E0 = __expf(of0 - gm0), E1 = __expf(of1 - gm1);     \
        unsigned kh0[4], kh1[4], vt0[4], vt1[4]; \
        _Pragma("unroll") for (int i = 0; i < 8; i += 2) { float a0[2], a1[2]; \
            _Pragma("unroll") for (int q = 0; q < 2; ++q) { const int ii = i + q, t = 8 * tg + ii; \
                const float f0 = __expf(bflo(gr_[ii])), f1 = __expf(bfhi(gr_[ii])); E0 *= f0; E1 *= f1; const float k0 = 1.0f - f0, k1 = 1.0f - f1; \
                const float q0 = bflo(qr_[ii]) * E0, q1 = bfhi(qr_[ii]) * E1; \
                const float kt0 = k0 * __builtin_amdgcn_rcpf(E0), kt1 = k1 * __builtin_amdgcn_rcpf(E1); a0[q] = kt0 * egd0; a1[q] = kt1 * egd1; \
                const unsigned so = t * 256 + 16 * ((unsigned)(dp >> 2) ^ (unsigned)(t & 15)) + 4 * (dp & 3); \
                *(LAS unsigned*)(QT_ + so) = pk2(q0, q1); *(LAS unsigned*)(KT_ + so) = pk2(kt0, kt1); } \
            kh0[i >> 1] = pk2(a0[0], a0[1]); kh1[i >> 1] = pk2(a1[0], a1[1]); \
            vt0[i >> 1] = (vr_[i] & 0xffffu) | (vr_[i + 1] << 16); vt1[i >> 1] = (vr_[i] >> 16) | (vr_[i + 1] & 0xffff0000u); } \
        { const unsigned d0_ = 2 * dp, d1_ = 2 * dp + 1; const unsigned o0 = d0_ * 128 + 16 * ((unsigned)tg ^ (d0_ & 7)), o1 = d1_ * 128 + 16 * ((unsigned)tg ^ (d1_ & 7)); \
          *(LAS v4u*)(KH_ + o0) = (v4u){kh0[0], kh0[1], kh0[2], kh0[3]}; *(LAS v4u*)(KH_ + o1) = (v4u){kh1[0], kh1[1], kh1[2], kh1[3]}; \
          *(LAS v4u*)(VT_ + o0) = (v4u){vt0[0], vt0[1], vt0[2], vt0[3]}; *(LAS v4u*)(VT_ + o1) = (v4u){vt1[0], vt1[1], vt1[2], vt1[3]}; } } while (0)
    SCAN_LOAD(0); SCAN_LOADN(1); SCAN_PREP1(); __syncthreads(); SCAN_PREP2(0u, EG); SCAN_LOADQV(1);
#pragma unroll
    for (int i = 0; i < 8; ++i) gr_[i] = gn_[i];
    __syncthreads();
    for (int c = 0; c < NCH; ++c) {
        const unsigned cur = (unsigned)(c & 1) * 65536u, nxt = 65536u - cur;
        const LAS unsigned char* QT = lds + cur; const LAS unsigned char* KT = QT + 16384; const LAS unsigned char* KH = QT + 32768; const LAS unsigned char* VT = QT + 49152;
        const LAS float* EGM = EG + (c & 1) * 256; const LAS float* EGE = EGM + 128; LAS float* EGN = EG + ((c & 1) ^ 1) * 256;
        const bool need_o = !(l == NLAYER - 1 && c < CTXL / 64);
        { const int cn = (c + 2 < NCH) ? c + 2 : NCH - 1; SCAN_LOADN(cn); }
        SCAN_PREP1();
        f32x4 acc[4];
#pragma unroll
        for (int i = 0; i < 4; ++i) acc[i] = (f32x4){0.f, 0.f, 0.f, 0.f};
        { const int ti = wid >> 1;
#pragma unroll
          for (int jj = 0; jj < 2; ++jj) { const int sj = 2 * (wid & 1) + jj; f32x4 sc = {0.f, 0.f, 0.f, 0.f};
              if (sj <= ti) { const int ra = 16 * ti + l15, rb = 16 * sj + l15;
#pragma unroll
                  for (int ks = 0; ks < 4; ++ks) { const bf16x8 av = *(const LAS bf16x8*)(QT + ra * 256 + 16 * ((4 * ks + g4) ^ (ra & 15))), bv = *(const LAS bf16x8*)(KT + rb * 256 + 16 * ((4 * ks + g4) ^ (rb & 15)));
                      sc = __builtin_amdgcn_mfma_f32_16x16x32_bf16(av, bv, sc, 0, 0, 0); } }
              const int s = 16 * sj + l15;
#pragma unroll
              for (int r = 0; r < 4; ++r) { const int t = 16 * ti + 4 * g4 + r; const float v = (s <= t) ? sc[r] : 0.f;
                  *(LAS unsigned short*)(PL + t * 128 + 16 * ((s >> 3) ^ (t & 7)) + 2 * (s & 7)) = (unsigned short)(pk2(v, 0.f) & 0xffffu); } }
          bf16x8 sb[4];
#pragma unroll
          for (int ks = 0; ks < 4; ++ks) { const f32x4 e0 = *(const LAS f32x4*)(EGM + 32 * ks + 4 * g4), e1 = *(const LAS f32x4*)(EGM + 32 * ks + 16 + 4 * g4); const f32x4 x0 = S[2 * ks] * e0, x1 = S[2 * ks + 1] * e1;
              v4u w; w.x = pk2(x0[0], x0[1]); w.y = pk2(x0[2], x0[3]); w.z = pk2(x1[0], x1[1]); w.w = pk2(x1[2], x1[3]); sb[ks] = __builtin_bit_cast(bf16x8, w); }
#pragma unroll
          for (int i = 0; i < 4; ++i) { const int ra = 16 * i + l15;
#pragma unroll
              for (int ks = 0; ks < 4; ++ks) { const v2u lo = *(const LAS v2u*)(QT + ra * 256 + 16 * ((4 * ks + (g4 >> 1)) ^ (ra & 15)) + 8 * (g4 & 1)), hi = *(const LAS v2u*)(QT + ra * 256 + 16 * ((4 * ks + 2 + (g4 >> 1)) ^ (ra & 15)) + 8 * (g4 & 1));
                  const v4u w = {lo.x, lo.y, hi.x, hi.y}; acc[i] = __builtin_amdgcn_mfma_f32_16x16x32_bf16(__builtin_bit_cast(bf16x8, w), sb[ks], acc[i], 0, 0, 0); } } }
        __syncthreads();
        SCAN_PREP2(nxt, EGN);
        { const int cq = (c + 2 < NCH) ? c + 2 : NCH - 1; SCAN_LOADQV(cq); }
        bf16x8 vt[2];
        { const int re = 16 * wid + l15;
#pragma unroll
          for (int ks = 0; ks < 2; ++ks) vt[ks] = *(const LAS bf16x8*)(VT + re * 128 + 16 * ((4 * ks + g4) ^ (re & 7))); }
#pragma unroll
        for (int i = 0; i < 4; ++i) { const int ra = 16 * i + l15;
#pragma unroll
            for (int ks = 0; ks < 2; ++ks) { const bf16x8 pv = *(const LAS bf16x8*)(PL + ra * 128 + 16 * ((4 * ks + g4) ^ (ra & 7))); acc[i] = __builtin_amdgcn_mfma_f32_16x16x32_bf16(pv, vt[ks], acc[i], 0, 0, 0); } }
        if (need_o) {
            LAS unsigned char* ot = lds + cur + wid * 2048;
#pragma unroll
            for (int i = 0; i < 4; ++i)
#pragma unroll
                for (int r = 0; r < 4; ++r) *(LAS unsigned short*)(ot + (16 * i + 4 * g4 + r) * 32 + 2 * l15) = (unsigned short)(pk2(acc[i][r], 0.f) & 0xffffu);
            asm volatile("s_waitcnt lgkmcnt(0)" ::: "memory");
            const v4u o0 = *(const LAS v4u*)(ot + lane * 32), o1 = *(const LAS v4u*)(ot + lane * 32 + 16);
            const int tau = 64 * c + lane; bf16* op = OUT + (rowbase + SCAN_POS(tau)) * ldo + h * 128 + 16 * wid;
            *(v4u*)op = o0; *(v4u*)(op + 8) = o1;
        }
#pragma unroll
        for (int db = 0; db < 8; ++db) { const f32x4 eg = *(const LAS f32x4*)(EGE + 16 * db + 4 * g4); S[db] = S[db] * eg; const int rd = 16 * db + l15;
#pragma unroll
            for (int ks = 0; ks < 2; ++ks) { const bf16x8 kv = *(const LAS bf16x8*)(KH + rd * 128 + 16 * ((4 * ks + g4) ^ (rd & 7))); S[db] = __builtin_amdgcn_mfma_f32_16x16x32_bf16(kv, vt[ks], S[db], 0, 0, 0); } }
#pragma unroll
        for (int i = 0; i < 8; ++i) gr_[i] = gn_[i];
        __syncthreads();
    }
#undef SCAN_LOAD
#undef SCAN_LOADN
#undef SCAN_LOADQV
#undef SCAN_POS
#undef SCAN_PREP1
#undef SCAN_PREP2
}

#define ATT_BIG 1.0995116e12f
#ifndef REP_ATTN
#define REP_ATTN 1
#endif
#ifndef REP_SCAN
#define REP_SCAN 1
#endif
#ifndef SCAN_MFMA
#define SCAN_MFMA 2
#endif
__device__ __forceinline__ int attn_unit(unsigned char* ws_, const float* gsub, LAS unsigned char* lds, int tid, int l, int bl, int h, int qb, unsigned* head, volatile LAS unsigned* misc) {
    const bf16* P = (const bf16*)(ws_ + WS_PROJ);
    const bf16* Q = P; const bf16* K = P + SEG_ELEMS; const bf16* V = P + 2 * SEG_ELEMS; bf16* AR = (bf16*)(ws_ + WS_AR);
    asm volatile("" : "+v"(tid));
    const int lane = tid & 63, wid = __builtin_amdgcn_readfirstlane(tid >> 6), r32 = lane & 31, hi = lane >> 5, mp = wid >> 2, qs = wid & 3;
    unsigned long long tp_acc = 0, tp_0 = 0;
#define ATP_START(c, w) do { if (PROBE_CLASS == (c) && wid == (w)) tp_0 = __builtin_amdgcn_s_memrealtime(); } while (0)
#define ATP_STOP(c, w) do { if (PROBE_CLASS == (c) && wid == (w)) tp_acc += __builtin_amdgcn_s_memrealtime() - tp_0; } while (0)
    ATP_START(26, 0); ATP_START(28, 0);
    const size_t rowbase = (size_t)bl * TPB; const int nkt = (qb < 2) ? (CTXL / 64) : (TPB / 64);
    const size_t qrow = rowbase + 128 * qb + 32 * qs + r32;
    bf16x8 qr[4];
#pragma unroll
    for (int d0 = 0; d0 < 4; ++d0) qr[d0] = *(const bf16x8*)(Q + qrow * 1024 + h * 128 + mp * 64 + d0 * 16 + hi * 8);
    const int srow = 4 * wid + (lane >> 4), pch = lane & 15;
    const unsigned ssw = ((srow & 3) << 2) | ((srow >> 2) & 3);
    const bf16* Kg = K + (rowbase + srow) * 1024 + h * 128 + ((unsigned)pch ^ ssw) * 8; const bf16* Vg = V + (rowbase + srow) * 1024 + h * 128 + ((unsigned)pch ^ ssw) * 8;
    const unsigned dw = (unsigned)wid * 1024u;
    const unsigned ldsb = (unsigned)(uintptr_t)lds + dw;
#define ATT_DMA1(gp, la_) do { unsigned keep_; asm volatile("s_mov_b32 %0, m0\n\ts_mov_b32 m0, %2\n\ts_nop 0\n\tglobal_load_lds_dwordx4 %1, off\n\ts_mov_b32 m0, %0" : "=&s"(keep_) : "v"(gp), "s"((unsigned)__builtin_amdgcn_readfirstlane(la_)) : "memory"); } while (0)
#define ATT_DMA_K(t) do { const unsigned b_ = ldsb + (unsigned)(((t) & 3) * 16384); ATT_DMA1(Kg + (size_t)(64 * (t)) * 1024, b_); ATT_DMA1(Kg + (size_t)(64 * (t) + 32) * 1024, b_ + 8192); } while (0)
#define ATT_DMA_V(t, slot_) do { const unsigned b_ = ldsb + 65536u + (unsigned)((slot_) * 16384); ATT_DMA1(Vg + (size_t)(64 * (t)) * 1024, b_); ATT_DMA1(Vg + (size_t)(64 * (t) + 32) * 1024, b_ + 8192); } while (0)
#define ATT_DMA_WAIT() asm volatile("s_waitcnt vmcnt(0)" ::: "memory")
    f32x16 o[4];
#pragma unroll
    for (int c = 0; c < 4; ++c)
#pragma unroll
        for (int r = 0; r < 16; ++r) o[c][r] = 0.f;
    float m_run, l_run;
    const int q4 = (lane & 15) >> 2, blk = (lane >> 4) & 1, pp = lane & 3;
    unsigned kbo[4], vbo[4][2];
    { const unsigned swk = ((r32 & 3) << 2) | ((r32 >> 2) & 3);
#pragma unroll
      for (int d0 = 0; d0 < 4; ++d0) kbo[d0] = 256u * r32 + 16u * ((unsigned)(mp * 8 + 2 * d0 + hi) ^ swk);
#pragma unroll
      for (int c = 0; c < 4; ++c)
#pragma unroll
          for (int x = 0; x < 2; ++x) vbo[c][x] = 2048u * x + 1024u * hi + 256u * q4 + 64u * ((unsigned)c ^ (unsigned)q4) + 16u * ((unsigned)(2 * blk + (pp >> 1)) ^ (unsigned)(2 * x + hi)) + 8u * (pp & 1); }
#define ATT_QK(Kb_) do { _Pragma("unroll") for (int r = 0; r < 16; ++r) { p0[r] = 0.f; p1[r] = 0.f; } \
        _Pragma("unroll") for (int d0 = 0; d0 < 4; ++d0) { const bf16x8 a0 = *(const LAS bf16x8*)((Kb_) + kbo[d0]), a1 = *(const LAS bf16x8*)((Kb_) + kbo[d0] + 8192); \
            p0 = __builtin_amdgcn_mfma_f32_32x32x16_bf16(a0, qr[d0], p0, 0, 0, 0); p1 = __builtin_amdgcn_mfma_f32_32x32x16_bf16(a1, qr[d0], p1, 0, 0, 0); } } while (0)
#define ATT_MAX3(a_, b_, c_) __builtin_fmaxf(__builtin_fmaxf((a_), (b_)), (c_))
#define ATT_ROWMAX(mx_) do { float a_ = ATT_MAX3(p0[0], p0[1], p1[0]), b_ = ATT_MAX3(p0[2], p0[3], p1[1]); a_ = ATT_MAX3(a_, p1[2], p1[3]); \
        _Pragma("unroll") for (int r = 4; r < 16; r += 4) { a_ = ATT_MAX3(a_, p0[r], p0[r + 1]); b_ = ATT_MAX3(b_, p0[r + 2], p0[r + 3]); a_ = ATT_MAX3(a_, p1[r], p1[r + 1]); b_ = ATT_MAX3(b_, p1[r + 2], p1[r + 3]); } \
        const float m_ = __builtin_fmaxf(a_, b_); const auto rr_ = __builtin_amdgcn_permlane32_swap(__float_as_uint(m_), __float_as_uint(m_), false, false); \
        mx_ = __builtin_fmaxf(__uint_as_float(rr_[0]), __uint_as_float(rr_[1])); } while (0)
#define ATT_PVSTEP(Vb_, c, s) do { const s16x4 lo_ = vtr((lds_cptr)((Vb_) + vbo[c][0] + 4096 * (s))), hh_ = vtr((lds_cptr)((Vb_) + vbo[c][1] + 4096 * (s))); \
        const bf16x8 va_ = {lo_[0], lo_[1], lo_[2], lo_[3], hh_[0], hh_[1], hh_[2], hh_[3]}; o[c] = __builtin_amdgcn_mfma_f32_32x32x16_bf16(va_, __builtin_bit_cast(bf16x8, pw[s]), o[c], 0, 0, 0); } while (0)
    f32x16 p0, p1; v4u pw[4];
    ATT_DMA_K(0); ATT_DMA_K(1); ATT_DMA_V(0, 0); ATT_DMA_WAIT(); __syncthreads();
    ATT_DMA_K(2); ATT_DMA_K(3); ATT_DMA_V(1, 1); ATT_DMA_V(2, 2);
    { const LAS unsigned char* Kb = lds; ATT_QK(Kb); float mx; ATT_ROWMAX(mx); m_run = bflo(pk2(mx, 0.f)); float ls = 0.f;
#pragma unroll
      for (int r = 0; r < 16; ++r) { p0[r] = __builtin_amdgcn_exp2f(p0[r] - m_run); p1[r] = __builtin_amdgcn_exp2f(p1[r] - m_run); ls += p0[r] + p1[r]; }
      l_run = ls;
      pw[0] = (v4u){cvtpk(p0[0], p0[1]), cvtpk(p0[2], p0[3]), cvtpk(p0[4], p0[5]), cvtpk(p0[6], p0[7])}; pw[1] = (v4u){cvtpk(p0[8], p0[9]), cvtpk(p0[10], p0[11]), cvtpk(p0[12], p0[13]), cvtpk(p0[14], p0[15])};
      pw[2] = (v4u){cvtpk(p1[0], p1[1]), cvtpk(p1[2], p1[3]), cvtpk(p1[4], p1[5]), cvtpk(p1[6], p1[7])}; pw[3] = (v4u){cvtpk(p1[8], p1[9]), cvtpk(p1[10], p1[11]), cvtpk(p1[12], p1[13]), cvtpk(p1[14], p1[15])}; }
#define ATT_VLOAD(dst, Vb_, c, sh) do { dst[0] = vtr((lds_cptr)((Vb_) + vbo[c][0] + 4096 * (2 * (sh)))); dst[1] = vtr((lds_cptr)((Vb_) + vbo[c][1] + 4096 * (2 * (sh)))); \
        dst[2] = vtr((lds_cptr)((Vb_) + vbo[c][0] + 4096 * (2 * (sh) + 1))); dst[3] = vtr((lds_cptr)((Vb_) + vbo[c][1] + 4096 * (2 * (sh) + 1))); } while (0)
#define ATT_PV1(src, c, s) do { const bf16x8 va_ = {src[2 * ((s) & 1)][0], src[2 * ((s) & 1)][1], src[2 * ((s) & 1)][2], src[2 * ((s) & 1)][3], src[2 * ((s) & 1) + 1][0], src[2 * ((s) & 1) + 1][1], src[2 * ((s) & 1) + 1][2], src[2 * ((s) & 1) + 1][3]}; \
        o[c] = __builtin_amdgcn_mfma_f32_32x32x16_bf16(va_, __builtin_bit_cast(bf16x8, pw[s]), o[c], 0, 0, 0); } while (0)
#define ATT_EXP2(E, P, r) asm volatile("v_exp_f32 %0, %3\n\tv_exp_f32 %1, %4\n\tv_add_f32 %2, %2, %0\n\tv_add_f32 %2, %2, %1" : "=&v"(E[r]), "=&v"(E[(r) + 1]), "+v"(ls) : "v"(P[r]), "v"(P[(r) + 1]))
#define ATT_EXP4(E, P, r) asm volatile("v_exp_f32 %0, %5\n\tv_exp_f32 %1, %6\n\tv_exp_f32 %2, %7\n\tv_exp_f32 %3, %8\n\tv_add_f32 %4, %4, %0\n\tv_add_f32 %4, %4, %1\n\tv_add_f32 %4, %4, %2\n\tv_add_f32 %4, %4, %3" : "=&v"(E[r]), "=&v"(E[(r) + 1]), "=&v"(E[(r) + 2]), "=&v"(E[(r) + 3]), "+v"(ls) : "v"(P[r]), "v"(P[(r) + 1]), "v"(P[(r) + 2]), "v"(P[(r) + 3]))
#define ATT_SB() __builtin_amdgcn_sched_barrier(0)
    ATP_STOP(28, 0); ATP_START(21, 0);
    int vs = 0;
    v4u kaug = {(hi == 0) ? 0x3f80u : 0u, 0u, 0u, 0u}, qaug = {(hi == 0) ? (pk2(-m_run, 0.f) & 0xffffu) : 0u, 0u, 0u, 0u};
    asm volatile("" : "+v"(kaug.x), "+v"(kaug.y), "+v"(kaug.z), "+v"(kaug.w));
    for (int t = 1; t < nkt; ++t) {
        if ((t & 1) == 0) { const int s2 = vs + 2 >= 5 ? vs - 3 : vs + 2, s3 = vs + 3 >= 5 ? vs - 2 : vs + 3; if (t + 2 < nkt) { ATT_DMA_K(t + 2); ATT_DMA_K(t + 3); ATT_DMA_V(t + 2, s3); } ATT_DMA_V(t + 1, s2); }
        ATP_START(24, 0); ATP_START(27, 4);
        const LAS unsigned char* Kb = lds + (t & 3) * 16384; const LAS unsigned char* Vb = lds + 65536 + vs * 16384;
        bf16x8 kf[4]; s16x4 va[4], vb[4];
#pragma unroll
        for (int d0 = 0; d0 < 4; ++d0) kf[d0] = *(const LAS bf16x8*)(Kb + kbo[d0]);
        ATT_VLOAD(va, Vb, 0, 0);
        ATT_SB();
        p0 = __builtin_amdgcn_mfma_f32_32x32x16_bf16(__builtin_bit_cast(bf16x8, kaug), __builtin_bit_cast(bf16x8, qaug), (f32x16){0.f}, 0, 0, 0);
#pragma unroll
        for (int d0 = 0; d0 < 4; ++d0) p0 = __builtin_amdgcn_mfma_f32_32x32x16_bf16(kf[d0], qr[d0], p0, 0, 0, 0);
#pragma unroll
        for (int d0 = 0; d0 < 4; ++d0) kf[d0] = *(const LAS bf16x8*)(Kb + kbo[d0] + 8192);
        ATT_VLOAD(vb, Vb, 0, 1);
        ATT_SB();
        p1 = __builtin_amdgcn_mfma_f32_32x32x16_bf16(__builtin_bit_cast(bf16x8, kaug), __builtin_bit_cast(bf16x8, qaug), (f32x16){0.f}, 0, 0, 0);
#pragma unroll
        for (int d0 = 0; d0 < 4; ++d0) p1 = __builtin_amdgcn_mfma_f32_32x32x16_bf16(kf[d0], qr[d0], p1, 0, 0, 0);
        ATT_SB();
        ATT_PV1(va, 0, 0); ATT_PV1(va, 0, 1);
        ATT_VLOAD(va, Vb, 1, 0);
        ATT_SB();
        ATT_PV1(vb, 0, 2); ATT_PV1(vb, 0, 3);
        ATT_SB();
        ATP_STOP(24, 0); ATP_STOP(27, 4);
        ATP_START(23, 4);
        if (mp == 1 && (t & 1)) { asm volatile("s_waitcnt vmcnt(0)\n\ts_barrier" ::: "memory"); }
        ATP_STOP(23, 4); ATP_START(25, 0);
        float ls = 0.f, e0[16], e1[16];
        ATT_VLOAD(vb, Vb, 1, 1);
        ATT_PV1(va, 1, 0); ATT_EXP4(e0, p0, 0); ATT_PV1(va, 1, 1); ATT_EXP4(e0, p0, 4);
        ATT_SB();
        ATT_VLOAD(va, Vb, 2, 0);
        ATT_PV1(vb, 1, 2); ATT_EXP4(e0, p0, 8); ATT_PV1(vb, 1, 3); ATT_EXP4(e0, p0, 12);
        ATT_SB();
        ATT_VLOAD(vb, Vb, 2, 1);
        ATT_PV1(va, 2, 0); ATT_EXP2(e1, p1, 0); ATT_PV1(va, 2, 1); ATT_EXP2(e1, p1, 2);
        ATT_SB();
        ATT_VLOAD(va, Vb, 3, 0);
        ATT_PV1(vb, 2, 2); ATT_EXP2(e1, p1, 4); ATT_PV1(vb, 2, 3); ATT_EXP2(e1, p1, 6);
        ATT_SB();
        ATT_VLOAD(vb, Vb, 3, 1);
        ATT_PV1(va, 3, 0); ATT_EXP2(e1, p1, 8); ATT_PV1(va, 3, 1); ATT_EXP2(e1, p1, 10);
        ATT_SB();
        ATT_PV1(vb, 3, 2); ATT_EXP2(e1, p1, 12); ATT_PV1(vb, 3, 3); ATT_EXP2(e1, p1, 14);
        ATT_SB();
        if (__any(!(ls < ATT_BIG))) {
            const bf16* Kt = K + (rowbase + (size_t)(64 * t) + r32) * 1024 + h * 128 + mp * 64 + hi * 8;
            p0 = __builtin_amdgcn_mfma_f32_32x32x16_bf16(__builtin_bit_cast(bf16x8, kaug), __builtin_bit_cast(bf16x8, qaug), (f32x16){0.f}, 0, 0, 0); p1 = p0;
#pragma unroll
            for (int d0 = 0; d0 < 4; ++d0) { const bf16x8 a0 = *(const bf16x8*)(Kt + d0 * 16), a1 = *(const bf16x8*)(Kt + 32 * 1024 + d0 * 16);
                p0 = __builtin_amdgcn_mfma_f32_32x32x16_bf16(a0, qr[d0], p0, 0, 0, 0); p1 = __builtin_amdgcn_mfma_f32_32x32x16_bf16(a1, qr[d0], p1, 0, 0, 0); }
            float mx; ATT_ROWMAX(mx);
            const float mn = bflo(pk2(m_run + fmaxf(mx, 0.f), 0.f)), dl = mn - m_run, al = __builtin_amdgcn_exp2f(-dl);
            m_run = mn; l_run *= al; qaug.x = (hi == 0) ? (pk2(-mn, 0.f) & 0xffffu) : 0u;
#pragma unroll
            for (int c = 0; c < 4; ++c)
#pragma unroll
                for (int r = 0; r < 16; ++r) o[c][r] *= al;
            ls = 0.f;
#pragma unroll
            for (int r = 0; r < 16; ++r) { e0[r] = __builtin_amdgcn_exp2f(p0[r] - dl); e1[r] = __builtin_amdgcn_exp2f(p1[r] - dl); ls += e0[r] + e1[r]; }
        }
        l_run += ls;
        pw[0] = (v4u){cvtpk(e0[0], e0[1]), cvtpk(e0[2], e0[3]), cvtpk(e0[4], e0[5]), cvtpk(e0[6], e0[7])}; pw[1] = (v4u){cvtpk(e0[8], e0[9]), cvtpk(e0[10], e0[11]), cvtpk(e0[12], e0[13]), cvtpk(e0[14], e0[15])};
        pw[2] = (v4u){cvtpk(e1[0], e1[1]), cvtpk(e1[2], e1[3]), cvtpk(e1[4], e1[5]), cvtpk(e1[6], e1[7])}; pw[3] = (v4u){cvtpk(e1[8], e1[9]), cvtpk(e1[10], e1[11]), cvtpk(e1[12], e1[13]), cvtpk(e1[14], e1[15])};
        ATP_STOP(25, 0); ATP_START(22, 0);
        if (mp == 0 && (t & 1)) { asm volatile("s_waitcnt vmcnt(0)\n\ts_barrier" ::: "memory"); }
        ATP_STOP(22, 0);
        vs = (vs == 4) ? 0 : vs + 1;
    }
    ATP_STOP(21, 0); ATP_START(29, 0);
    unsigned nx_ = 0; if (tid == 0) nx_ = __hip_atomic_fetch_add(head, 1u, RLX_AGENT);
#undef ATT_VLOAD
#undef ATT_PV1
#undef ATT_EXP2
#undef ATT_EXP4
#undef ATT_SB
    { const LAS unsigned char* Vb = lds + 65536 + vs * 16384;
#pragma unroll
      for (int c = 0; c < 4; ++c)
#pragma unroll
          for (int s = 0; s < 4; ++s) ATT_PVSTEP(Vb, c, s); }
    __syncthreads();
#undef ATT_DMA_K
#undef ATT_DMA_V
#undef ATT_DMA1
#undef ATT_DMA_WAIT
#undef ATT_QK
#undef ATT_ROWMAX
#undef ATT_MAX3
#undef ATT_PVSTEP
    l_run += __shfl_xor(l_run, 32);
    const float inv = 1.0f / l_run;
    LAS float* X = (LAS float*)lds;
    if (mp == 1) {
#pragma unroll
        for (int c = 0; c < 4; ++c)
#pragma unroll
            for (int r = 0; r < 16; ++r) X[((qs * 4 + c) * 16 + r) * 64 + lane] = o[c][r] * inv;
    }
    __syncthreads();
    if (mp == 0) {
        int lo_ = l; asm volatile("" : "+s"(lo_));
        const float lam = ((const float*)(ws_ + WS_MISC))[l]; const float osc = 1.0f - (0.8f - 0.6f * __expf(-0.3f * (float)lo_));
        float ss = 0.f;
#pragma unroll
        for (int c = 0; c < 4; ++c)
#pragma unroll
            for (int r = 0; r < 16; ++r) { const float v = o[c][r] * inv - lam * X[((qs * 4 + c) * 16 + r) * 64 + lane]; o[c][r] = v; ss += v * v; }
        ss += __shfl_xor(ss, 32);
        const float rstd = rsqrtf(ss * (1.f / 128.f) + EPS) * osc; const float* gs = gsub + l * 128;
#pragma unroll
        for (int ch = 0; ch < 4; ch += 2) {
            asm volatile("" ::: "memory");
            f32x4 gq[2][4];
#pragma unroll
            for (int c = 0; c < 2; ++c)
#pragma unroll
                for (int rg = 0; rg < 4; ++rg) gq[c][rg] = *(const f32x4*)(gs + 32 * (ch + c) + 8 * rg + 4 * hi);
            asm volatile("" ::: "memory");
#pragma unroll
            for (int c2 = 0; c2 < 2; ++c2)
#pragma unroll
                for (int rg = 0; rg < 4; ++rg) { const int c = ch + c2, dv = 32 * c + 8 * rg + 4 * hi; const f32x4 g4 = gq[c2][rg];
                    v2u w; w.x = pk2(o[c][4 * rg] * rstd * g4.x, o[c][4 * rg + 1] * rstd * g4.y); w.y = pk2(o[c][4 * rg + 2] * rstd * g4.z, o[c][4 * rg + 3] * rstd * g4.w);
                    *(v2u*)(AR + qrow * 2048 + h * 128 + dv) = w; }
        }
    }
    if (tid == 0) misc[0] = nx_;
    __syncthreads();
    const int unext_ = __builtin_amdgcn_readfirstlane((int)misc[0]);
    ATP_STOP(26, 0); ATP_STOP(29, 0);
    if (PROBE_CLASS >= 21 && PROBE_CLASS <= 29 && blockIdx.x == 0 && lane == 0 && tp_acc != 0) __hip_atomic_fetch_add((unsigned long long*)(ws_ + (size_t)CW_PROBE * 4), tp_acc, __ATOMIC_RELAXED, __HIP_MEMORY_SCOPE_AGENT);
#undef ATP_START
#undef ATP_STOP
    return unext_;
}

constexpr int RP_UNITS = 512;
__device__ __forceinline__ void phase_mixer(unsigned char* ws_, const float* gsub, const float* grec, int l, int g, LAS unsigned char* lds, volatile LAS unsigned* misc, int tid, int rep) {
    unsigned* head = (unsigned*)(ws_ + WS_CTL) + CW_QUEUE + 64 * (l * NGRP + g + 4 * rep);
    unsigned* sdone = (unsigned*)(ws_ + WS_CTL) + CW_SCAN + 64 * (l * NGRP + g);
    const int nscan = NBG * 8 * 2, nqb = (l == 0) ? 18 : 16, natt = NBG * 8 * nqb;
    const int nrp_rows = (l == NLAYER - 1) ? NBG * SEQ : GT, rp_chunk = nrp_rows / RP_UNITS;
    const int lane = tid & 63, wave = __builtin_amdgcn_readfirstlane(tid >> 6);
    bool scan_pending = false;
    int unext = -1;
    for (;;) {
        int u;
        if (unext >= 0) { u = unext; unext = -1; } else {
        asm volatile("s_waitcnt vmcnt(0)" ::: "memory");
        __syncthreads();
        if (tid == 0) {
            if (scan_pending) { __builtin_amdgcn_fence(__ATOMIC_RELEASE, "agent"); asm volatile("s_waitcnt vmcnt(0)" ::: "memory"); __hip_atomic_fetch_add(sdone, 1u, RLX_AGENT); }
            misc[0] = __hip_atomic_fetch_add(head, 1u, RLX_AGENT);
        }
        __syncthreads();
        u = __builtin_amdgcn_readfirstlane((int)misc[0]);
        __syncthreads();
        scan_pending = false; }
        if (u >= nscan + natt + RP_UNITS) break;
        unsigned char* wsu = ws_; const float* gsub_u = gsub; const float* grec_u = grec; asm volatile("" : "+s"(wsu), "+s"(gsub_u), "+s"(grec_u));
        if (u < nscan) {
            if (SCAN_MFMA == 2) scan_unit_pipe(wsu, lds, tid, l, u >> 4, (u >> 1) & 7, u & 1); else if (SCAN_MFMA) { for (int rs_ = 0; rs_ < REP_SCAN; ++rs_) scan_unit_mfma(wsu, lds, tid, l, u >> 4, (u >> 1) & 7, u & 1); } else scan_unit(wsu, lds, tid, u >> 4, (u >> 1) & 7, u & 1);
            scan_pending = true;
        } else if (u < nscan + natt) { const int v = u - nscan; const int nbig = NBG * 8 * 16; int bh, qb; if (v < nbig) { bh = v >> 4; qb = 2 + (v & 15); } else { const int w = v - nbig; bh = w >> 1; qb = w & 1; }
            unext = attn_unit(wsu, gsub_u, lds, tid, l, bh >> 3, bh & 7, qb, head, misc); }
        else {
            if (tid == 0) { unsigned sp = 0; while (__hip_atomic_load(sdone, RLX_AGENT) < (unsigned)nscan) { __builtin_amdgcn_s_sleep(2); if (++sp > (1u << 20)) break; }
                __builtin_amdgcn_fence(__ATOMIC_ACQUIRE, "agent"); asm volatile("s_waitcnt vmcnt(0)" ::: "memory"); }
            __syncthreads();
            const int c = u - nscan - natt;
            rprep_range(wsu, grec_u, l, c * rp_chunk + wave, (c + 1) * rp_chunk, NWAVES, lane);
        }
    }
    asm volatile("s_waitcnt vmcnt(0)" ::: "memory");
}

#ifndef MK_SINGLE
#define MK_SINGLE 1
#endif
#ifndef REP_MIXER
#define REP_MIXER 1
#endif
#ifndef REP_GEMM
#define REP_GEMM 1
#endif
#ifndef REP_THIN
#define REP_THIN 1
#endif
#ifndef REP_X
#define REP_X 1
#endif
#ifndef REP_OUT
#define REP_OUT 1
#endif
#ifndef REP_MOE
#define REP_MOE 1
#endif
constexpr int PH_PER_GROUP = 9;
constexpr int N_PHASES = 1 + 1 + NLAYER * NGRP * (PH_PER_GROUP - 1);

__global__ void __launch_bounds__(NTHREADS, 2) fwd_kernel(Args args) {
    extern __shared__ __attribute__((aligned(16))) unsigned char lds_raw[];
    LAS unsigned char* lds = (LAS unsigned char*)lds_raw;
    volatile LAS unsigned* MISC = (volatile LAS unsigned*)(lds + MISC_OFF);
    const int G = gridDim.x, bx = blockIdx.x, vcu = (G % 8 == 0) ? (bx % 8) * (G / 8) + bx / 8 : bx;
    const int ngw = G * NWAVES;
#define IDS() int tid_ = threadIdx.x; asm volatile("" : "+v"(tid_)); const int tid = tid_, lane = tid & 63, wave = __builtin_amdgcn_readfirstlane(tid >> 6), gw = vcu * NWAVES + wave; (void)lane; (void)gw; (void)wave
#if defined(__HIP_DEVICE_COMPILE__)
#define KA() const __attribute__((address_space(4))) Args* kap_ = (const __attribute__((address_space(4))) Args*)__builtin_amdgcn_kernarg_segment_ptr(); asm volatile("" : "+s"(kap_)); const Args la = *kap_; unsigned char* ws = la.ws; (void)ws
#else
#define KA() const Args la = args; unsigned char* ws = la.ws; (void)ws
#endif
    unsigned* ctl = (unsigned*)(args.ws + WS_CTL);
    for (int u = threadIdx.x; u < (LDS_BYTES - LDSCTL_OFF) / 4; u += NTHREADS) ((LAS unsigned*)(lds + LDSCTL_OFF))[u] = 0u;
    __syncthreads();
    const int lo = args.ph_lo, hi = args.ph_hi;
    XcdBarrier bar; bar.bar = ctl + CW_BAR; bar.x = 0; bar.st = nullptr;
    if (hi - lo > 1) bar = xcd_barrier_post(ctl + CW_BAR, MISC + 8);
#define IN(k) (lo <= (k) && (k) < hi)
#ifndef REP_BAR
#define REP_BAR 1
#endif
#define SEAM(k) do { if (IN(k) && IN((k) + 1)) { for (int rb_ = 0; rb_ < REP_BAR; ++rb_) xcd_barrier(bar); } } while (0)

#ifndef PROBE_CLASS
#define PROBE_CLASS 0
#endif
    unsigned long long t_acc = 0, t_0 = 0; (void)t_0;
#define TSTART(c) do { if (PROBE_CLASS == (c)) t_0 = __builtin_amdgcn_s_memrealtime(); } while (0)
#define TSTOP(c) do { if (PROBE_CLASS == (c)) t_acc += __builtin_amdgcn_s_memrealtime() - t_0; } while (0)
    int pid = 0;
    TSTART(6);
    if (IN(pid)) { KA(); for (int rep = 0; rep < REP_THIN; ++rep) { __syncthreads(); { IDS(); phase_prologue(la, lds, tid, G); } __syncthreads(); { IDS(); phase_weights(la, 0, lds, gw, ngw, wave, lane); } } }
    SEAM(pid); TSTOP(6); ++pid;

    for (int l = 0; l < NLAYER; ++l) {
        for (int g = 0; g < NGRP; ++g) {
            const int mode = (l == NLAYER - 1) ? 1 : 0;
            const bool first = (l == 0 && g == 0);
            const int fl_ = (g + 1 < NGRP) ? l : l + 1, fg_ = (g + 1 < NGRP) ? g + 1 : 0; const bool ftar = fl_ < NLAYER; bool fdone = false;
#define FILL() do { if (ftar && !fdone) { IDS(); fdone = fill_norm1(la, fl_, fg_, MISC, tid, wave, lane); } } while (0)
            TSTART(7);
            if (first) {
            if (IN(pid)) { KA(); for (int rep = 0; rep < REP_THIN; ++rep) { IDS(); phase_norm1(la, l, g, gw, ngw, lane); } }
            SEAM(pid); TSTOP(7); ++pid; }
            TSTART(2);
            if (IN(pid)) { KA();
                pg8::Gemm gm{(const bf16*)(ws + (first ? WS_AR : WS_HN)), (const bf16*)(ws + WS_WIN), GT, NIN, 1024};
                DenseOrder S; S.init((l == NLAYER - 1) ? 2 : 0, NIN / 256, G, bx);
                EpiInProj E{(bf16*)(ws + WS_PROJ), (const float*)(ws + WS_ROPE), (const float*)(ws + WS_ROPE) + 2048 * 32, (const float*)(ws + WS_MISC) + 256 + l * 1024, l == 0};
                for (int rep = 0; rep < REP_GEMM; ++rep) pg8::gemm_phase<EpiInProj, DenseOrder, true, true>(lds, gm, S, E);
                if (first) FILL();
            }
            SEAM(pid); TSTOP(2); ++pid;
            TSTART(1);
            if (IN(pid)) { KA(); for (int rep = 0; rep < REP_MIXER; ++rep) { IDS(); phase_mixer(la.ws, la.in[13], la.in[15], l, g, lds, MISC, tid, rep); } }
            SEAM(pid); TSTOP(1); ++pid;
            TSTART(3);
            if (IN(pid)) { KA();
                pg8::Gemm gm{(const bf16*)(ws + WS_AR), (const bf16*)(ws + WS_WAR), GT, 1024, 2048};
                DenseOrder S; S.init(mode, 4, G, bx);
                EpiMix E{(const bf16*)(ws + WS_PROJ) + 8 * SEG_ELEMS, (const bf16*)(ws + WS_PROJ) + 9 * SEG_ELEMS, (bf16*)(ws + WS_MIX)};
                for (int rep = 0; rep < REP_GEMM; ++rep) pg8::gemm_phase<EpiMix, DenseOrder, true, true>(lds, gm, S, E);
                FILL();
            }
            SEAM(pid); TSTOP(3); ++pid;
            TSTART(3);
            if (IN(pid)) { KA();
                pg8::Gemm gm{(const bf16*)(ws + WS_MIX), (const bf16*)(ws + WS_WO), GT, 1024, 1024};
                DenseOrder S; S.init(mode, 4, G, bx);
                for (int rep = REP_OUT - 1; rep >= 0; --rep) {
                EpiOut E{(l == 0) ? la.in[0] : la.out, rep ? ((float*)(ws + WS_DUMMY) - (size_t)g * NBG * SEQ * 1024) : la.out, (l == 0) ? la.in[2] : (const float*)(ws + WS_XC), rep ? ((float*)(ws + WS_DUMMY + 64 * MiB) - (size_t)g * NBG * CTXL * 1024) : (float*)(ws + WS_XC), (const float*)(ws + WS_MOD) + (size_t)l * 17 * 6144, g * NBG};
                pg8::gemm_phase<EpiOut, DenseOrder, true, true>(lds, gm, S, E); }
                FILL();
            }
            SEAM(pid); TSTOP(3); ++pid;
            TSTART(9);
            if (IN(pid)) { KA(); for (int rep = REP_X - 1; rep >= 0; --rep) { __syncthreads(); IDS(); phase_route(la, l, g, lds, tid, gw, ngw, lane, rep); } }
            SEAM(pid); TSTOP(9); ++pid;
            TSTART(4);
            if (IN(pid)) { KA();
                int t0_ = threadIdx.x; asm volatile("" : "+v"(t0_));
                const int nt = moe_tables(ws, l, g, lds, t0_);
                pg8::Gemm gm{(const bf16*)(ws + WS_H2S), (const bf16*)(ws + WS_WUP), GT, 2048, 1024};
                LAS int* tl = (LAS int*)(lds + TILE_OFF); LAS int* gl = (LAS int*)(lds + GIDX_OFF);
                MoeOrder<8, true> S; S.init(tl, nt, G, vcu, gl);
                { const LAS int* cn = (const LAS int*)(lds + MOECN_OFF); const LAS int* ex = (const LAS int*)(lds + MOEEX_OFF); const int* list = (const int*)(ws + WS_LIST);
                  pg8::Unit uu;
                  for (int ui = 0; ui < GIDX_UNITS && S.next(ui, uu); ++ui) if (t0_ < 256) { const int e = tl[uu.pm], pos = 256 * (uu.pm - (ex[e] >> 8)) + t0_; gl[ui * 256 + t0_] = (pos < cn[e]) ? ldg_i(list + e * GT + pos) : 0; } }
                __syncthreads();
                EpiUp E{(bf16*)(ws + WS_HID)};
                for (int rep = 0; rep < REP_MOE; ++rep) pg8::gemm_phase<EpiUp, MoeOrder<8, true>, true, true>(lds, gm, S, E);
            }
            SEAM(pid); TSTOP(4); ++pid;
            TSTART(4);
            if (IN(pid)) { KA();
                int t0_ = threadIdx.x; asm volatile("" : "+v"(t0_));
                const int nt = moe_tables(ws, l, g, lds, t0_);
                pg8::Gemm gm{(const bf16*)(ws + WS_HID), (const bf16*)(ws + WS_WDN), MAXSLOT, 1024, 1024};
                LAS int* tl = (LAS int*)(lds + TILE_OFF);
                MoeOrder<4> S; S.init(tl, nt, G, vcu);
                EpiDown E{(bf16*)(ws + WS_YE)};
                for (int rep = 0; rep < REP_MOE; ++rep) pg8::gemm_phase<EpiDown, MoeOrder<4>, true, true>(lds, gm, S, E);
                FILL();
            }
            SEAM(pid); TSTOP(4); ++pid;
            TSTART(11);
            if (IN(pid)) { KA();
                for (int rep = REP_X - 1; rep >= 0; --rep) { IDS(); phase_combine(la, l, g, gw, ngw, lane, rep); }
                FILL();
                if (l + 1 < NLAYER && g == NGRP - 1) { for (int rep = 0; rep < REP_THIN; ++rep) { IDS(); phase_weights(la, l + 1, lds, gw, ngw, wave, lane); } }
            }
            SEAM(pid); TSTOP(11); ++pid;
#undef FILL
        }
    }
    if (PROBE_CLASS >= 21 && PROBE_CLASS <= 29 && blockIdx.x == 0) { __syncthreads(); KA(); t_acc = __hip_atomic_load((const unsigned long long*)(ws + (size_t)CW_PROBE * 4), __ATOMIC_RELAXED, __HIP_MEMORY_SCOPE_AGENT); }
    if (PROBE_CLASS != 0 && blockIdx.x == 0) { const unsigned long long te = __builtin_amdgcn_s_memrealtime(); while (__builtin_amdgcn_s_memrealtime() - te < t_acc) __builtin_amdgcn_s_sleep(8); }
#undef IN
#undef SEAM
}

extern "C" void kernel_launch(void* const* d_in, const int* in_sizes, int n_in, void* d_out, int out_size, void* d_ws, size_t ws_size, hipStream_t stream) {
    static int grid = 0;
    if (grid == 0) {
        if (n_in != 25 || out_size != NBATCH * SEQ * D || ws_size < WS_END) { fprintf(stderr, "kernel_launch: unexpected shapes (n_in %d out %d ws %zu need %zu)\n", n_in, out_size, ws_size, (size_t)WS_END); grid = -1; return; }
        int dev = 0, cus = 0, per_cu = 0;
        if (hipGetDevice(&dev) != hipSuccess || hipDeviceGetAttribute(&cus, hipDeviceAttributeMultiprocessorCount, dev) != hipSuccess) { grid = -1; return; }
        if (hipFuncSetAttribute((const void*)fwd_kernel, hipFuncAttributeMaxDynamicSharedMemorySize, LDS_BYTES) != hipSuccess) { fprintf(stderr, "kernel_launch: hipFuncSetAttribute failed\n"); grid = -1; return; }
        if (hipOccupancyMaxActiveBlocksPerMultiprocessor(&per_cu, (const void*)fwd_kernel, NTHREADS, LDS_BYTES) != hipSuccess || per_cu < 1) { fprintf(stderr, "kernel_launch: occupancy query says %d blocks per CU\n", per_cu); }
        (void)hipGetLastError();
        grid = cus;
    }
    if (grid < 0) return;
    if (hipMemsetAsync((char*)d_ws + WS_CTL, 0, CTL_ZERO_BYTES, stream) != hipSuccess) return;
    Args a{};
    for (int i = 0; i < 25; ++i) a.in[i] = (const float*)d_in[i];
    a.out = (float*)d_out; a.ws = (unsigned char*)d_ws;
#if MK_SINGLE
    a.ph_lo = 0; a.ph_hi = N_PHASES;
    hipLaunchKernelGGL(fwd_kernel, dim3(grid), dim3(NTHREADS), LDS_BYTES, stream, a);
#else
    for (int p = 0; p < N_PHASES; ++p) { a.ph_lo = p; a.ph_hi = p + 1; hipLaunchKernelGGL(fwd_kernel, dim3(grid), dim3(NTHREADS), LDS_BYTES, stream, a); }
#endif
}
```

```cpp
#include <hip/hip_runtime.h>
#include <cstdio>
#include <cstdint>
namespace pg8 {
#define PG8_LAS __attribute__((address_space(3)))
typedef unsigned short bf16_t;
typedef short bf16x8 __attribute__((ext_vector_type(8)));
typedef float f32x4 __attribute__((ext_vector_type(4)));
typedef unsigned u32x4 __attribute__((ext_vector_type(4)));
constexpr int BM = 256, BK = 64, HALF = 128, HTB = HALF * BK * 2  , STAGE_BYTES = 8 * HTB, NXCD = 8, WGM = 8;

__host__ __device__ __forceinline__ int lds_byte(int r, int c) { const int st = (r >> 4) * 2 + (c >> 5), rr = r & 15, cc = c & 31, ob = rr * 64 + cc * 2; return st * 1024 + (ob ^ (((ob >> 9) & 1) << 5)); }
__host__ __device__ __forceinline__ void stage_rc(int b, int& R, int& C) { const int st = b / 1024, sb = b % 1024, swz = sb ^ (((sb >> 9) & 1) << 5); R = (st >> 1) * 16 + swz / 64; C = (st & 1) * 32 + (swz % 64) / 2; }
__host__ __device__ __forceinline__ int perm32(int rho) { const int n = rho >> 4, i = rho & 15; return 8 * (i >> 2) + 4 * n + (i & 3); }

struct Unit { int pm, pn; };
struct Gemm { const bf16_t* A; const bf16_t* Bt; int M, N, K; };
__device__ __forceinline__ unsigned cvt_pk_bf16(float lo, float hi) { unsigned r; asm volatile("v_cvt_pk_bf16_f32 %0, %1, %2" : "=v"(r) : "v"(lo), "v"(hi)); return r; }
template <class Epi, class Sched, bool ALIGN_EPI = false, bool SP2 = false>
__device__ __forceinline__ void gemm_phase(PG8_LAS unsigned char* lds, const Gemm g, const Sched& S, const Epi& E) {
    int tid_ = threadIdx.x; asm volatile("" : "+v"(tid_));
    const int tid = tid_, wid = __builtin_amdgcn_readfirstlane(tid >> 6), lane = tid & 63, wr = wid >> 2, wc = wid & 3, fr = lane & 15, fq = lane >> 4;
    const int K = g.K, nt = K / BK;
    unsigned voffA[2], voffB[2];
#pragma unroll
    for (int i = 0; i < 2; ++i) { int R, C; stage_rc(tid * 16 + i * 8192, R, C); const int Rb = Epi::PERM ? ((R & ~31) + perm32(R & 31)) : R;
        voffA[i] = (unsigned)(R * K + C) * 2u; voffB[i] = (unsigned)(Rb * K + C) * 2u; }
    const size_t kstep = (size_t)(BK * 2);
    const size_t hstep = (size_t)HALF * K * 2;
    const size_t tstep = 2 * hstep;
    constexpr bool GA = Sched::GATHER;
    const size_t hstepA = GA ? 0 : hstep, tstepA = GA ? 0 : tstep;
    unsigned cvo[2][2], nvo[2][2];
#define PG8_GOFF(ui_, vo) do { _Pragma("unroll") for (int h_ = 0; h_ < 2; ++h_) _Pragma("unroll") for (int i_ = 0; i_ < 2; ++i_) { int R_, C_; stage_rc(tid * 16 + i_ * 8192, R_, C_); \
        vo[h_][i_] = (unsigned)S.gidx[(ui_) * 256 + h_ * 128 + R_] * (unsigned)(K * 2) + (unsigned)(C_ * 2); } } while (0)
#define PG8_STAGE_A(bufoff, gbase, H, NX) do { if constexpr (GA) { if (NX) PG8_STAGE(bufoff, gbase, nvo[H]); else PG8_STAGE(bufoff, gbase, cvo[H]); } else PG8_STAGE(bufoff, gbase, voffA); } while (0)
    const unsigned ldsw = (unsigned)wid * 1024u;
    const int aoff = lds_byte(wr * 64 + fr, fq * 8), boff = lds_byte(wc * 32 + fr, fq * 8);
#define PG8_SA(b, h) (((b) * 2 + (h)) * HTB)
#define PG8_SB(b, h) ((4 + (b) * 2 + (h)) * HTB)
#define PG8_STAGE(bufoff, gbase, voff) do { _Pragma("unroll") for (int _i = 0; _i < 2; ++_i) \
        __builtin_amdgcn_global_load_lds((const unsigned*)((const char*)(gbase) + (voff)[_i]), (PG8_LAS unsigned*)(lds + (bufoff) + ldsw + _i * 8192), 16, 0, 0); } while (0)
#define PG8_LDA(dst, b, h) do { _Pragma("unroll") for (int m = 0; m < 4; ++m) _Pragma("unroll") for (int k = 0; k < 2; ++k) dst[m][k] = *(const PG8_LAS bf16x8*)(lds + PG8_SA(b, h) + aoff + m * 2048 + k * 1024); } while (0)
#define PG8_LDB(dst, b, h) do { _Pragma("unroll") for (int n = 0; n < 2; ++n) _Pragma("unroll") for (int k = 0; k < 2; ++k) dst[n][k] = *(const PG8_LAS bf16x8*)(lds + PG8_SB(b, h) + boff + n * 2048 + k * 1024); } while (0)
#define PG8_MMA(ai, bj, At, Bt) do { __builtin_amdgcn_s_setprio(1); _Pragma("unroll") for (int m = 0; m < 4; ++m) _Pragma("unroll") for (int n = 0; n < 2; ++n) _Pragma("unroll") for (int k = 0; k < 2; ++k) \
        acc[ai][bj][m][n] = __builtin_amdgcn_mfma_f32_16x16x32_bf16(Bt[n][k], At[m][k], acc[ai][bj][m][n], 0, 0, 0); __builtin_amdgcn_s_setprio(0); } while (0)
#define PG8_WAIT_V(n) asm volatile("s_waitcnt vmcnt(" #n ")" ::: "memory")
#define PG8_WAIT_L(n) asm volatile("s_waitcnt lgkmcnt(" #n ")" ::: "memory")
#define PG8_BAR __builtin_amdgcn_s_barrier()
#define PG8_SCHED __builtin_amdgcn_sched_barrier(0)
    Unit cur, nxt; int ui = 0;
    if (!S.next(0, cur)) return;
    f32x4 acc[2][2][4][2];
#pragma unroll
    for (int a = 0; a < 2; ++a)
#pragma unroll
        for (int b = 0; b < 2; ++b)
#pragma unroll
            for (int m = 0; m < 4; ++m)
#pragma unroll
                for (int n = 0; n < 2; ++n) acc[a][b][m][n] = (f32x4){0.f, 0.f, 0.f, 0.f};
    bf16x8 At[4][2], B0[2][2], B1[2][2];
    const char* cA = (const char*)g.A + (size_t)cur.pm * tstepA; const char* cB = (const char*)g.Bt + (size_t)cur.pn * tstep;
    S.a_ready(cur);
    if constexpr (GA) { PG8_GOFF(0, cvo); }
    if constexpr (SP2) {
        PG8_STAGE(PG8_SB(0, 0), cB, voffB); PG8_STAGE(PG8_SB(0, 1), cB + hstep, voffB); PG8_STAGE_A(PG8_SA(0, 0), cA, 0, false); PG8_STAGE_A(PG8_SA(0, 1), cA + hstepA, 1, false);
        if (wr == 1) PG8_BAR;
        PG8_WAIT_V(2); PG8_BAR;
        PG8_STAGE(PG8_SB(1, 0), cB + kstep, voffB); PG8_STAGE_A(PG8_SA(1, 0), cA + kstep, 0, false); PG8_STAGE(PG8_SB(1, 1), cB + hstep + kstep, voffB);
        PG8_WAIT_V(6); PG8_BAR;
    } else {
        PG8_STAGE(PG8_SB(0, 0), cB, voffB); PG8_STAGE(PG8_SA(0, 0), cA, voffA); PG8_STAGE(PG8_SB(0, 1), cB + hstep, voffB); PG8_STAGE(PG8_SA(0, 1), cA + hstep, voffA);
        if (wr == 1) PG8_BAR;
        PG8_WAIT_V(4); PG8_BAR;
        PG8_STAGE(PG8_SB(1, 0), cB + kstep, voffB); PG8_STAGE(PG8_SA(1, 0), cA + kstep, voffA); PG8_STAGE(PG8_SB(1, 1), cB + hstep + kstep, voffB);
        PG8_WAIT_V(6); PG8_BAR;
    }
    for (;;) {
        const bool has_next = S.next(ui + 1, nxt);
        if constexpr (GA) { if (has_next) { PG8_GOFF(ui + 1, nvo); } else { _Pragma("unroll") for (int h_ = 0; h_ < 2; ++h_) _Pragma("unroll") for (int i_ = 0; i_ < 2; ++i_) nvo[h_][i_] = cvo[h_][i_]; } }
        const char* nA = has_next ? (const char*)g.A + (size_t)nxt.pm * tstepA : cA; const char* nB = has_next ? (const char*)g.Bt + (size_t)nxt.pn * tstep : cB;
        for (int t = 0; t < nt; t += 2) {
            if constexpr (Epi::HAS_MID) { if (t == (nt >> 1)) E.mid(acc, cur, wr, wc, fr, fq); }
            const bool last = (t == nt - 2);
            const char* a1 = cA + (size_t)(t + 1) * kstep;
            const char* a2 = last ? nA : cA + (size_t)(t + 2) * kstep; const char* b2 = last ? nB : cB + (size_t)(t + 2) * kstep;
            const char* a3 = a2 + kstep; const char* b3 = b2 + kstep;
            if (last && has_next) S.a_ready(nxt);
            if constexpr (SP2) {
            PG8_LDB(B0, 0, 0); PG8_LDB(B1, 0, 1); PG8_SCHED; PG8_LDA(At, 0, 0); PG8_STAGE_A(PG8_SA(1, 1), a1 + hstepA, 1, false);
            PG8_WAIT_V(8); PG8_WAIT_L(0); PG8_BAR; PG8_MMA(0, 0, At, B0); PG8_MMA(0, 1, At, B1); PG8_BAR; PG8_SCHED;
            PG8_LDA(At, 0, 1); PG8_STAGE(PG8_SB(0, 0), b2, voffB); PG8_STAGE(PG8_SB(0, 1), b2 + hstep, voffB); PG8_STAGE_A(PG8_SA(0, 0), a2, 0, last);
            PG8_WAIT_V(8); PG8_WAIT_L(0); PG8_BAR; PG8_MMA(1, 0, At, B0); PG8_MMA(1, 1, At, B1); PG8_BAR; PG8_SCHED;
            PG8_LDB(B0, 1, 0); PG8_LDB(B1, 1, 1); PG8_SCHED; PG8_LDA(At, 1, 0); PG8_STAGE_A(PG8_SA(0, 1), a2 + hstepA, 1, last);
            PG8_WAIT_V(8); PG8_WAIT_L(0); PG8_BAR; PG8_MMA(0, 0, At, B0); PG8_MMA(0, 1, At, B1); PG8_BAR; PG8_SCHED;
            PG8_LDA(At, 1, 1); PG8_STAGE(PG8_SB(1, 0), b3, voffB); PG8_STAGE(PG8_SB(1, 1), b3 + hstep, voffB); PG8_STAGE_A(PG8_SA(1, 0), a3, 0, last);
            PG8_WAIT_V(8); PG8_WAIT_L(0); PG8_BAR; PG8_MMA(1, 0, At, B0); PG8_MMA(1, 1, At, B1); PG8_BAR; PG8_SCHED;
            } else {
            PG8_LDB(B0, 0, 0); PG8_SCHED; PG8_LDA(At, 0, 0); PG8_STAGE(PG8_SA(1, 1), a1 + hstep, voffA);
            PG8_WAIT_L(8); PG8_BAR; PG8_WAIT_L(0); PG8_MMA(0, 0, At, B0); PG8_BAR; PG8_SCHED;
            PG8_LDB(B1, 0, 1); PG8_STAGE(PG8_SB(0, 0), b2, voffB);
            PG8_BAR; PG8_WAIT_L(0); PG8_MMA(0, 1, At, B1); PG8_BAR;
            PG8_LDA(At, 0, 1); PG8_STAGE(PG8_SA(0, 0), a2, voffA);
            PG8_BAR; PG8_WAIT_L(0); PG8_MMA(1, 0, At, B0); PG8_BAR; PG8_SCHED;
            PG8_STAGE(PG8_SB(0, 1), b2 + hstep, voffB);
            PG8_WAIT_V(6); PG8_BAR; PG8_MMA(1, 1, At, B1); PG8_BAR;
            PG8_LDB(B0, 1, 0); PG8_SCHED; PG8_LDA(At, 1, 0); PG8_STAGE(PG8_SA(0, 1), a2 + hstep, voffA);
            PG8_WAIT_L(8); PG8_BAR; PG8_WAIT_L(0); PG8_MMA(0, 0, At, B0); PG8_BAR; PG8_SCHED;
            PG8_LDB(B1, 1, 1); PG8_STAGE(PG8_SB(1, 0), b3, voffB);
            PG8_BAR; PG8_WAIT_L(0); PG8_MMA(0, 1, At, B1); PG8_BAR;
            PG8_LDA(At, 1, 1); PG8_STAGE(PG8_SA(1, 0), a3, voffA);
            PG8_BAR; PG8_WAIT_L(0); PG8_MMA(1, 0, At, B0); PG8_BAR; PG8_SCHED;
            PG8_STAGE(PG8_SB(1, 1), b3 + hstep, voffB);
            PG8_WAIT_V(6); PG8_BAR; PG8_MMA(1, 1, At, B1); PG8_BAR;
            }
        }
        if constexpr (ALIGN_EPI) { if (wr == 0) PG8_BAR; }
        if constexpr (!Epi::AFTER_DRAIN) { E(acc, cur, wr, wc, fr, fq); S.done(cur); }
        if (!has_next) break;
#pragma unroll
        for (int a = 0; a < 2; ++a)
#pragma unroll
            for (int b = 0; b < 2; ++b)
#pragma unroll
                for (int m = 0; m < 4; ++m)
#pragma unroll
                    for (int n = 0; n < 2; ++n) acc[a][b][m][n] = (f32x4){0.f, 0.f, 0.f, 0.f};
        cur = nxt; cA = nA; cB = nB; ++ui;
        if constexpr (GA) { _Pragma("unroll") for (int h_ = 0; h_ < 2; ++h_) _Pragma("unroll") for (int i_ = 0; i_ < 2; ++i_) cvo[h_][i_] = nvo[h_][i_]; }
        if constexpr (ALIGN_EPI) { if (wr == 1) PG8_BAR; }
    }
    PG8_WAIT_V(0);
    if constexpr (!ALIGN_EPI) { if (wr == 0) PG8_BAR; }
    PG8_BAR;
    if constexpr (Epi::AFTER_DRAIN) { E.fused(acc, cur, wr, wc, fr, fq, lds, wid, lane); S.done(cur); }
#undef PG8_SA
#undef PG8_SB
#undef PG8_STAGE
#undef PG8_STAGE_A
#undef PG8_GOFF
#undef PG8_LDA
#undef PG8_LDB
#undef PG8_MMA
#undef PG8_WAIT_V
#undef PG8_WAIT_L
#undef PG8_BAR
#undef PG8_SCHED
}
}
#define GAS __attribute__((address_space(1)))
#define LAS __attribute__((address_space(3)))
#define XB_TMO      128
#define XB_XCNT(j)  (256  + 64 * (j))
#define XB_XSUB(j)  (1280 + 64 * (j))
#define XB_XGEN(j)  (2304 + 64 * (j))
#define XB_TOP      3328
#define XB_TOPGEN   3392
#define XCD_BAR_WORDS 3456
#define XB_SPIN_CAP (1u << 18)

__device__ __forceinline__ unsigned xb_ld(unsigned* p)              { return __hip_atomic_load(p, __ATOMIC_RELAXED, __HIP_MEMORY_SCOPE_AGENT); }
__device__ __forceinline__ unsigned xb_add(unsigned* p, unsigned v) { return __hip_atomic_fetch_add(p, v, __ATOMIC_RELAXED, __HIP_MEMORY_SCOPE_AGENT); }
__device__ __forceinline__ unsigned xb_xcc_id() { return (unsigned)__builtin_amdgcn_s_getreg((3 << 11) | 20) & 0xFu; }
#define XB_SPIN(cond, bar) do { unsigned _sp = 0; while (cond) { __builtin_amdgcn_s_sleep(1); \
    if ((++_sp & 255u) == 0u) { if (xb_ld(&(bar)[XB_TMO])) break; if (_sp > XB_SPIN_CAP) { atomicAdd(&(bar)[XB_TMO], 1u); break; } } } } while (0)

struct XcdBarrier {
    unsigned* bar; unsigned x;
    volatile LAS unsigned* st;
};

__device__ __forceinline__ XcdBarrier xcd_barrier_post(unsigned* bar, volatile LAS unsigned* st) {
    XcdBarrier b; b.bar = bar; b.x = xb_xcc_id(); b.st = st;
    if (threadIdx.x == 0) (void)xb_add(&bar[XB_XCNT(b.x)], 1u);
    return b;
}
__device__ __forceinline__ void xcd_barrier_complete(unsigned* bar, unsigned x, unsigned& nloc, unsigned& nx) {
    const unsigned G = gridDim.x * gridDim.y * gridDim.z;
    unsigned sum, cnt, mine, sp = 0u;
    for (;;) {
        sum = 0u; cnt = 0u; mine = 0u;
#pragma unroll
        for (unsigned j = 0; j < 16; ++j) { const unsigned c = xb_ld(&bar[XB_XCNT(j)]); sum += c; cnt += (c > 0u) ? 1u : 0u; mine = (j == x) ? c : mine; }
        if (sum == G) break;
        __builtin_amdgcn_s_sleep(1);
        if ((++sp & 255u) == 0u) { if (xb_ld(&bar[XB_TMO])) break; if (sp > XB_SPIN_CAP) { atomicAdd(&bar[XB_TMO], 1u); break; } }
    }
    nloc = mine > 0u ? mine : 1u; nx = cnt > 0u ? cnt : 1u;
}

__device__ __forceinline__ void xcd_barrier(const XcdBarrier& b) {
    asm volatile("s_waitcnt vmcnt(0)" ::: "memory");
    __syncthreads();
    if (threadIdx.x == 0) {
        unsigned* bar = b.bar;
        __builtin_amdgcn_s_waitcnt(0);
        unsigned nloc = b.st[0], nx = b.st[1];
        if (nloc == 0u) { xcd_barrier_complete(bar, b.x, nloc, nx); b.st[0] = nloc; b.st[1] = nx; }
        const unsigned old = xb_add(&bar[XB_XSUB(b.x)], 1u);
        const unsigned gen = old / nloc;
        if (old + 1u == (gen + 1u) * nloc) {
            __builtin_amdgcn_fence(__ATOMIC_RELEASE, "agent");
            asm volatile("s_waitcnt vmcnt(0)" ::: "memory");
            const unsigned og = xb_add(&bar[XB_TOP], 1u);
            const unsigned tg = og / nx;
            if (og + 1u == (tg + 1u) * nx) xb_add(&bar[XB_TOPGEN], 1u);
            else XB_SPIN(xb_ld(&bar[XB_TOPGEN]) == tg, bar);
            __builtin_amdgcn_fence(__ATOMIC_ACQUIRE, "agent");
            xb_add(&bar[XB_XGEN(b.x)], 1u);
            asm volatile("s_waitcnt vmcnt(0)" ::: "memory");
        } else {
            XB_SPIN(xb_ld(&bar[XB_XGEN(b.x)]) == gen, bar);
            __builtin_amdgcn_fence(__ATOMIC_ACQUIRE, "agent");
            asm volatile("s_waitcnt vmcnt(0)" ::: "memory");
        }
    }
    __syncthreads();
}

typedef unsigned short bf16;
typedef unsigned v4u __attribute__((ext_vector_type(4)));
typedef unsigned v2u __attribute__((ext_vector_type(2)));
typedef float f32x4 __attribute__((ext_vector_type(4)));
typedef float f32x2 __attribute__((ext_vector_type(2)));
typedef float f32x16 __attribute__((ext_vector_type(16)));
typedef short bf16x8 __attribute__((ext_vector_type(8)));
typedef short s16x4 __attribute__((ext_vector_type(4)));

constexpr int D = 1024, NBATCH = 16, SEQ = 2048, CTXL = 256, TPB = CTXL + SEQ, NLAYER = 2;
constexpr int NBG = 8, NGRP = NBATCH / NBG, GT = NBG * TPB, GTILES = GT / 256;
constexpr int NIN = 10240, NEXP = 16, NWAVES = 8, NTHREADS = NWAVES * 64;
constexpr float EPS = 1e-6f;
constexpr float QSCALE = 0.125f * 1.4426950408889634f;
constexpr size_t MiB = 1u << 20;
constexpr size_t WS_CTL = 0, CTL_ZERO_BYTES = 1 * MiB;
constexpr size_t WS_MOD = 1 * MiB;
constexpr size_t WS_ROPE = 2 * MiB;
constexpr size_t WS_MISC = 2 * MiB + 512 * 1024;
constexpr size_t WS_ROUTE = 3 * MiB;
constexpr size_t WS_XC = 4 * MiB;
constexpr size_t WS_WIN = 20 * MiB;
constexpr size_t WS_WAR = 40 * MiB;
constexpr size_t WS_WO = 44 * MiB;
constexpr size_t WS_WUP = 46 * MiB;
constexpr size_t WS_WDN = 110 * MiB;
constexpr size_t WS_PROJ = 142 * MiB;
constexpr size_t SEG_ELEMS = (size_t)GT * 1024;
constexpr size_t WS_AR = 502 * MiB;
constexpr size_t WS_OB = 574 * MiB;
constexpr size_t WS_HN = 610 * MiB;
constexpr size_t WS_END = 646 * MiB;
constexpr int MAXSLOT = 2 * GT + NEXP * 256;
constexpr size_t WS_H2S = 142 * MiB, WS_HID = 222 * MiB, WS_YE = 302 * MiB;
constexpr size_t WS_LIST = WS_H2S + 40 * MiB;
constexpr int GIDX_OFF = 131072, GIDX_UNITS = 8, MOECN_OFF = GIDX_OFF + GIDX_UNITS * 1024, MOEEX_OFF = MOECN_OFF + 64;
constexpr size_t WS_MIX = WS_PROJ;
constexpr size_t WS_DUMMY = 382 * MiB;
static_assert(WS_YE + (size_t)MAXSLOT * 2048 <= WS_AR && WS_PROJ + 10 * SEG_ELEMS * 2 <= WS_AR && WS_AR + (size_t)GT * 4096 <= WS_OB && WS_OB + SEG_ELEMS * 2 <= WS_HN && WS_HN + SEG_ELEMS * 2 <= WS_END, "ws map");
constexpr int RT_E = 0, RT_P = GT * 8, RT_W = 2 * GT * 8, RT_S = 3 * GT * 8;
#ifndef PROBE_CLASS
#define PROBE_CLASS 0
#endif
constexpr int CW_FILL = 36864;
constexpr int CW_PROBE = 32768;
constexpr int CW_BAR = 4096;
constexpr int CW_QUEUE = 16384;
constexpr int CW_SCAN = 18432;
constexpr int CW_CNT = 20480;
constexpr int RING_BYTES = 131072, LDSCTL_OFF = 147456, MISC_OFF = LDSCTL_OFF + 320, TILE_OFF = LDSCTL_OFF + 1024, LDS_BYTES = 149504;

#define RLX_AGENT __ATOMIC_RELAXED, __HIP_MEMORY_SCOPE_AGENT
__device__ __forceinline__ unsigned f2bf(float f) { unsigned u = __builtin_bit_cast(unsigned, f); return (u + 0x7fffu + ((u >> 16) & 1u)) >> 16; }
typedef __bf16 bf16x2_t __attribute__((ext_vector_type(2)));
__device__ __forceinline__ unsigned pk2(float lo, float hi) { f32x2 v = {lo, hi}; bf16x2_t b = __builtin_convertvector(v, bf16x2_t); return __builtin_bit_cast(unsigned, b); }
__device__ __forceinline__ float bf2f(unsigned short b) { return __builtin_bit_cast(float, (unsigned)b << 16); }
__device__ __forceinline__ float bflo(unsigned w) { return __builtin_bit_cast(float, w << 16); }
__device__ __forceinline__ float bfhi(unsigned w) { return __builtin_bit_cast(float, w & 0xffff0000u); }
__device__ __forceinline__ float sigmoidf_(float z) { return __builtin_amdgcn_rcpf(1.0f + __expf(-z)); }
__device__ __forceinline__ float wave_sum(float v) {
#pragma unroll
    for (int o = 1; o < 64; o <<= 1) v += __shfl_xor(v, o);
    return v;
}

__device__ __forceinline__ int ldg_i(const int* p) { return (int)__hip_atomic_load((const unsigned*)p, RLX_AGENT); }
__device__ __forceinline__ float ldg_f(const float* p) { return __builtin_bit_cast(float, __hip_atomic_load((const unsigned*)p, RLX_AGENT)); }

struct Args { const float* in[25]; float* out; unsigned char* ws; int ph_lo, ph_hi; };

#ifndef WGM_
#define WGM_ 4
#endif
#ifndef REP_EPIINPROJ
#define REP_EPIINPROJ 1
#endif
#ifndef REP_EPIMIX
#define REP_EPIMIX 1
#endif
#ifndef REP_EPIOUT
#define REP_EPIOUT 1
#endif
#ifndef REP_EPIUP
#define REP_EPIUP 1
#endif
#ifndef REP_EPIDOWN
#define REP_EPIDOWN 1
#endif
struct DenseOrder {
    static constexpr bool GATHER = false;
    int mode, nM, nN, nwg, G, c, extra;
    __device__ void init(int mode_, int nN_, int G_, int c_) { mode = mode_; nM = (mode == 0) ? GTILES : NBG * 8; nN = nN_; nwg = nM * nN; G = G_; c = c_; extra = (mode == 2) ? NBG * 20 : 0; }
    __device__ bool next(int i, pg8::Unit& u) const {
        const int L = i * G + c; if (L >= nwg + extra) return false;
        if (L >= nwg) { const int r = L - nwg, bi = r / 20, ci = r % 20, sg = ci >> 2; u.pm = bi * 9; u.pn = ((sg == 0) ? 1 : (sg == 1) ? 2 : (sg + 2)) * 4 + (ci & 3); return true; }
        int wgid = L; { const int q = nwg / 8, r = nwg % 8, xcd = wgid % 8, off = wgid / 8; wgid = (xcd < r ? xcd * (q + 1) : r * (q + 1) + (xcd - r) * q) + off; }
        const int nig = WGM_ * nN, gid = wgid / nig, fm = gid * WGM_, gsz = (nM - fm) < WGM_ ? (nM - fm) : WGM_;
        const int pml = fm + ((wgid % nig) % gsz); u.pn = (wgid % nig) / gsz;
        u.pm = (mode == 0) ? pml : (pml >> 3) * 9 + 1 + (pml & 7);
        return true;
    }
    __device__ __forceinline__ void a_ready(const pg8::Unit&) const {}
    __device__ __forceinline__ void done(const pg8::Unit&) const {}
};
template <int NPN, bool GA = false> struct MoeOrder {
    static constexpr bool GATHER = GA;
    const LAS int* gidx;
    const LAS int* tile_e; int nunits, G, c;
    __device__ void init(const LAS int* te, int nt, int G_, int c_, const LAS int* gi = nullptr) { tile_e = te; nunits = nt * NPN; G = G_; c = c_; gidx = gi; }
    __device__ __forceinline__ bool next(int i, pg8::Unit& u) const {
        const int L = i * G + c; if (L >= nunits) return false;
        const int tm = L / NPN, pl = L % NPN; u.pm = tm; u.pn = __builtin_amdgcn_readfirstlane(tile_e[tm]) * NPN + pl; return true;
    }
    __device__ __forceinline__ void a_ready(const pg8::Unit&) const {}
    __device__ __forceinline__ void done(const pg8::Unit&) const {}
};

struct EpiInProj {
    static constexpr int REPS = REP_EPIINPROJ;
    static constexpr bool PERM = true, AFTER_DRAIN = false, HAS_MID = false;
    bf16* proj; const float* ropec; const float* ropes; const float* lb; bool lbzero;
    __device__ __forceinline__ void operator()(const pg8::f32x4 (&acc)[2][2][4][2], const pg8::Unit& u, int wr, int wc, int fr_, int fq_) const {
        int fr = fr_, fq = fq_; asm volatile("" : "+v"(fr), "+v"(fq));
        const int seg = u.pn >> 2, tb = u.pm % 9; const bool lat = tb != 0;
        bf16* base = proj + (size_t)seg * SEG_ELEMS;
        const int colb = (u.pn & 3) * 256 + wc * 32 + 8 * fq;
        f32x4 lbv[2][2];
#pragma unroll
        for (int bj = 0; bj < 2; ++bj) { lbv[bj][0] = (f32x4){0.f, 0.f, 0.f, 0.f}; lbv[bj][1] = lbv[bj][0]; if ((seg == 4 || seg == 5) && !lbzero) { lbv[bj][0] = *(const f32x4*)(lb + colb + bj * 128); lbv[bj][1] = *(const f32x4*)(lb + colb + bj * 128 + 4); } }
#pragma unroll
        for (int ai = 0; ai < 2; ++ai)
#pragma unroll
          for (int mp = 0; mp < 4; mp += 2) {
            f32x4 csv[2], snv[2];
#pragma unroll
            for (int mm = 0; mm < 2; ++mm) { csv[mm] = (f32x4){1.f, 1.f, 1.f, 1.f}; snv[mm] = (f32x4){0.f, 0.f, 0.f, 0.f};
                if (seg < 2 && lat) { const int t = (tb - 1) * 256 + ai * 128 + wr * 64 + (mp + mm) * 16 + fr; csv[mm] = *(const f32x4*)(ropec + t * 32 + (wc & 1) * 16 + 4 * fq); snv[mm] = *(const f32x4*)(ropes + t * 32 + (wc & 1) * 16 + 4 * fq); } }
#pragma unroll
            for (int mm = 0; mm < 2; ++mm) { const int m = mp + mm;
                const int rl = ai * 128 + wr * 64 + m * 16 + fr; const size_t row = (size_t)u.pm * 256 + rl;
                const f32x4 cs = csv[mm], sn = snv[mm];
#pragma unroll
                for (int bj = 0; bj < 2; ++bj) {
                    f32x4 v0 = acc[ai][bj][m][0], v1 = acc[ai][bj][m][1];
                    if (seg < 2) {
                        const f32x4 a = v0 * cs - v1 * sn, b = v0 * sn + v1 * cs; v0 = a; v1 = b;
                        if (seg == 0) { v0 = v0 * QSCALE; v1 = v1 * QSCALE; }
                    } else if (seg == 4 || seg == 5) {
                        const f32x4 l0 = lbv[bj][0], l1 = lbv[bj][1];
#pragma unroll
                        for (int j = 0; j < 4; ++j) {
                            if (lbzero) { const float z0 = v0[j], z1 = v1[j]; v0[j] = fminf(z0, 0.f) - __logf(1.0f + __expf(-fabsf(z0))); v1[j] = fminf(z1, 0.f) - __logf(1.0f + __expf(-fabsf(z1))); }
                            else { const float z0 = v0[j], z1 = v1[j]; v0[j] = __logf(l0[j] + (1.0f - l0[j]) * sigmoidf_(z0)); v1[j] = __logf(l1[j] + (1.0f - l1[j]) * sigmoidf_(z1)); }
                        }
                    } else if (seg == 7) {
#pragma unroll
                        for (int j = 0; j < 4; ++j) { v0[j] = v0[j] * sigmoidf_(v0[j]); v1[j] = v1[j] * sigmoidf_(v1[j]); }
                    } else if (seg >= 8) {
#pragma unroll
                        for (int j = 0; j < 4; ++j) { v0[j] = sigmoidf_(v0[j]); v1[j] = sigmoidf_(v1[j]); }
                    }
                    v4u w; w.x = pk2(v0[0], v0[1]); w.y = pk2(v0[2], v0[3]); w.z = pk2(v1[0], v1[1]); w.w = pk2(v1[2], v1[3]);
                    *(v4u*)(base + row * 1024 + colb + bj * 128) = w;
                }
            }
            asm volatile("" ::: "memory");
          }
    }
};
struct EpiMix {
    static constexpr int REPS = REP_EPIMIX;
    static constexpr bool PERM = true, AFTER_DRAIN = false, HAS_MID = true;
    const bf16* ga; const bf16* gr; bf16* mix;
    __device__ __forceinline__ void mid(pg8::f32x4 (&acc)[2][2][4][2], const pg8::Unit& u, int wr, int wc, int fr_, int fq_) const {
        int fr = fr_, fq = fq_; asm volatile("" : "+v"(fr), "+v"(fq));
        const int colb = u.pn * 256 + wc * 32 + 8 * fq;
#pragma unroll
        for (int ai = 0; ai < 2; ++ai)
#pragma unroll
            for (int mp = 0; mp < 4; mp += 2) { v4u av[2][2], rv[2][2];
#pragma unroll
                for (int mm = 0; mm < 2; ++mm) { const size_t row = (size_t)u.pm * 256 + ai * 128 + wr * 64 + (mp + mm) * 16 + fr;
#pragma unroll
                    for (int bj = 0; bj < 2; ++bj) { av[mm][bj] = *(const v4u*)(ga + row * 1024 + colb + bj * 128); rv[mm][bj] = *(const v4u*)(gr + row * 1024 + colb + bj * 128); } }
#pragma unroll
                for (int mm = 0; mm < 2; ++mm)
#pragma unroll
                    for (int bj = 0; bj < 2; ++bj) { const v4u a = av[mm][bj], r = rv[mm][bj]; const int m_ = mp + mm;
                        f32x4 q0, q1;
                        q0[0] = bflo(a.x) * __builtin_amdgcn_rcpf(bflo(r.x)); q0[1] = bfhi(a.x) * __builtin_amdgcn_rcpf(bfhi(r.x)); q0[2] = bflo(a.y) * __builtin_amdgcn_rcpf(bflo(r.y)); q0[3] = bfhi(a.y) * __builtin_amdgcn_rcpf(bfhi(r.y));
                        q1[0] = bflo(a.z) * __builtin_amdgcn_rcpf(bflo(r.z)); q1[1] = bfhi(a.z) * __builtin_amdgcn_rcpf(bfhi(r.z)); q1[2] = bflo(a.w) * __builtin_amdgcn_rcpf(bflo(r.w)); q1[3] = bfhi(a.w) * __builtin_amdgcn_rcpf(bfhi(r.w));
                        acc[ai][bj][m_][0] = acc[ai][bj][m_][0] * q0; acc[ai][bj][m_][1] = acc[ai][bj][m_][1] * q1; }
                asm volatile("" ::: "memory"); }
    }
    __device__ __forceinline__ void operator()(const pg8::f32x4 (&acc)[2][2][4][2], const pg8::Unit& u, int wr, int wc, int fr_, int fq_) const {
        int fr = fr_, fq = fq_; asm volatile("" : "+v"(fr), "+v"(fq));
        const int colb = u.pn * 256 + wc * 32 + 8 * fq;
#pragma unroll
        for (int ai = 0; ai < 2; ++ai) { v4u rv[4][2];
#pragma unroll
            for (int m = 0; m < 4; ++m) { const size_t row = (size_t)u.pm * 256 + ai * 128 + wr * 64 + m * 16 + fr;
#pragma unroll
                for (int bj = 0; bj < 2; ++bj) rv[m][bj] = *(const v4u*)(gr + row * 1024 + colb + bj * 128); }
#pragma unroll
            for (int m = 0; m < 4; ++m) { const size_t row = (size_t)u.pm * 256 + ai * 128 + wr * 64 + m * 16 + fr;
#pragma unroll
                for (int bj = 0; bj < 2; ++bj) { const v4u r = rv[m][bj];
                    const f32x4 v0 = acc[ai][bj][m][0], v1 = acc[ai][bj][m][1]; v4u w;
                    w.x = pk2(v0[0] * bflo(r.x), v0[1] * bfhi(r.x)); w.y = pk2(v0[2] * bflo(r.y), v0[3] * bfhi(r.y));
                    w.z = pk2(v1[0] * bflo(r.z), v1[1] * bfhi(r.z)); w.w = pk2(v1[2] * bflo(r.w), v1[3] * bfhi(r.w));
                    *(v4u*)(mix + row * 1024 + colb + bj * 128) = w; } }
            asm volatile("" ::: "memory"); }
    }
};
struct EpiOut {
    static constexpr int REPS = REP_EPIOUT;
    static constexpr bool PERM = false, AFTER_DRAIN = false, HAS_MID = false;
    const float* xsrc; float* xdst; const float* csrc; float* cdst; const float* mod; int bg0;
    __device__ __forceinline__ void operator()(const pg8::f32x4 (&acc)[2][2][4][2], const pg8::Unit& u, int wr, int wc, int fr_, int fq_) const {
        int fr = fr_, fq = fq_; asm volatile("" : "+v"(fr), "+v"(fq));
        const int bl = u.pm / 9, tb = u.pm % 9, bgl = bg0 + bl; const bool lat = tb != 0;
        const float* gate = mod + (size_t)(lat ? bgl : 16) * 6144 + 2 * 1024;
        const int colb = u.pn * 256 + wc * 32 + 4 * fq;
        f32x4 gv[2][2];
#pragma unroll
        for (int bj = 0; bj < 2; ++bj)
#pragma unroll
            for (int n = 0; n < 2; ++n) gv[bj][n] = *(const f32x4*)(gate + colb + bj * 128 + n * 16);
#pragma unroll
        for (int ai = 0; ai < 2; ++ai)
#pragma unroll
            for (int mp = 0; mp < 4; mp += 2) { f32x4 xv[2][2][2];
#pragma unroll
                for (int mm = 0; mm < 2; ++mm) { const int rl = ai * 128 + wr * 64 + (mp + mm) * 16 + fr;
                    const size_t xr = lat ? ((size_t)bgl * SEQ + (tb - 1) * 256 + rl) : ((size_t)bgl * CTXL + rl); const float* s = (lat ? xsrc : csrc) + xr * 1024;
#pragma unroll
                    for (int bj = 0; bj < 2; ++bj)
#pragma unroll
                        for (int n = 0; n < 2; ++n) xv[mm][bj][n] = *(const f32x4*)(s + colb + bj * 128 + n * 16); }
#pragma unroll
                for (int mm = 0; mm < 2; ++mm) { const int rl = ai * 128 + wr * 64 + (mp + mm) * 16 + fr;
                    const size_t xr = lat ? ((size_t)bgl * SEQ + (tb - 1) * 256 + rl) : ((size_t)bgl * CTXL + rl); float* d = (lat ? xdst : cdst) + xr * 1024;
#pragma unroll
                    for (int bj = 0; bj < 2; ++bj)
#pragma unroll
                        for (int n = 0; n < 2; ++n) *(f32x4*)(d + colb + bj * 128 + n * 16) = xv[mm][bj][n] + gv[bj][n] * acc[ai][bj][mp + mm][n]; }
                asm volatile("" ::: "memory"); }
    }
};
struct EpiUp {
    static constexpr int REPS = REP_EPIUP;
    static constexpr bool PERM = false, AFTER_DRAIN = false, HAS_MID = false;
    bf16* hid;
    __device__ __forceinline__ void operator()(const pg8::f32x4 (&acc)[2][2][4][2], const pg8::Unit& u, int wr, int wc, int fr_, int fq_) const {
        int fr = fr_, fq = fq_; asm volatile("" : "+v"(fr), "+v"(fq));
        const int jb = (u.pn & 7) * 128 + wc * 16 + 4 * fq;
#pragma unroll
        for (int ai = 0; ai < 2; ++ai)
#pragma unroll
            for (int m = 0; m < 4; ++m) { const size_t row = (size_t)u.pm * 256 + ai * 128 + wr * 64 + m * 16 + fr;
#pragma unroll
                for (int bj = 0; bj < 2; ++bj) { const f32x4 g = acc[ai][bj][m][0], up = acc[ai][bj][m][1]; f32x4 h;
#pragma unroll
                    for (int j = 0; j < 4; ++j) h[j] = g[j] * sigmoidf_(g[j]) * up[j];
                    v2u w; w.x = pk2(h[0], h[1]); w.y = pk2(h[2], h[3]); *(v2u*)(hid + row * 1024 + jb + bj * 64) = w; } asm volatile("" ::: "memory"); }
    }
};
struct EpiDown {
    static constexpr int REPS = REP_EPIDOWN;
    static constexpr bool PERM = true, AFTER_DRAIN = false, HAS_MID = false;
    bf16* ye;
    __device__ __forceinline__ void operator()(const pg8::f32x4 (&acc)[2][2][4][2], const pg8::Unit& u, int wr, int wc, int fr_, int fq_) const {
        int fr = fr_, fq = fq_; asm volatile("" : "+v"(fr), "+v"(fq));
        const int colb = (u.pn & 3) * 256 + wc * 32 + 8 * fq;
#pragma unroll
        for (int ai = 0; ai < 2; ++ai)
#pragma unroll
            for (int m = 0; m < 4; ++m) { const size_t row = (size_t)u.pm * 256 + ai * 128 + wr * 64 + m * 16 + fr;
#pragma unroll
                for (int bj = 0; bj < 2; ++bj) { const f32x4 v0 = acc[ai][bj][m][0], v1 = acc[ai][bj][m][1]; v4u w;
                    w.x = pk2(v0[0], v0[1]); w.y = pk2(v0[2], v0[3]); w.z = pk2(v1[0], v1[1]); w.w = pk2(v1[2], v1[3]);
                    *(v4u*)(ye + row * 1024 + colb + bj * 128) = w; } asm volatile("" ::: "memory"); }
    }
};

template <int RMAP> __device__ __forceinline__ void transpose_item(const float* W, int N, bf16* WT, int ldk, int koff, LAS float* scr, int item, int lane) {
    const int nblk = N / 32, kb = item / nblk, nb = item % nblk, k0 = 64 * kb, n0 = 32 * nb;
    { f32x4 wv[8]; const int r_ = lane >> 3, c4 = lane & 7;
#pragma unroll
      for (int i = 0; i < 8; ++i) wv[i] = *(const f32x4*)(W + (size_t)(k0 + 8 * i + r_) * N + n0 + 4 * c4);
#pragma unroll
      for (int i = 0; i < 8; ++i) { LAS float* d_ = scr + (8 * i + r_) * 33 + 4 * c4; d_[0] = wv[i].x; d_[1] = wv[i].y; d_[2] = wv[i].z; d_[3] = wv[i].w; } }
    asm volatile("s_waitcnt lgkmcnt(0)" ::: "memory");
    const int c = lane & 7;
#pragma unroll
    for (int j = 0; j < 4; ++j) { const int nl = (lane >> 3) + 8 * j; const LAS float* s = scr + (8 * c) * 33 + nl; const int n = n0 + nl;
        const int d_ = n & 31; const int row = (RMAP == 0) ? n : (RMAP == 3) ? ((n < 2048) ? ((n & ~31) + 8 * ((d_ >> 2) & 3) + 4 * (d_ >> 4) + (d_ & 3)) : n) : ((n >> 4) * 32 + (n & 15) + (RMAP == 2 ? 16 : 0));
        v4u o; o.x = pk2(s[0 * 33], s[1 * 33]); o.y = pk2(s[2 * 33], s[3 * 33]); o.z = pk2(s[4 * 33], s[5 * 33]); o.w = pk2(s[6 * 33], s[7 * 33]);
        *(v4u*)(WT + (size_t)row * ldk + koff + k0 + 8 * c) = o; }
    asm volatile("s_waitcnt lgkmcnt(0)" ::: "memory");
}
__device__ __forceinline__ void phase_weights(const Args& a, int l, LAS unsigned char* lds, int gw, int ngw, int wave, int lane) {
    LAS float* scr = (LAS float*)(lds + wave * 16384);
    unsigned char* ws = a.ws;
    constexpr int I_IN = 16 * (NIN / 32), I_SQ = 16 * 32;
    constexpr int NITEMS = I_IN + 3 * I_SQ + NEXP * 3 * I_SQ;
    for (int it = gw; it < NITEMS; it += ngw) {
        int r = it;
        if (r < I_IN) { transpose_item<3>(a.in[8] + (size_t)l * 1024 * NIN, NIN, (bf16*)(ws + WS_WIN), 1024, 0, scr, r, lane); continue; } r -= I_IN;
        if (r < I_SQ) { transpose_item<0>(a.in[16] + (size_t)l * 1048576, 1024, (bf16*)(ws + WS_WAR), 2048, 0, scr, r, lane); continue; } r -= I_SQ;
        if (r < I_SQ) { transpose_item<0>(a.in[17] + (size_t)l * 1048576, 1024, (bf16*)(ws + WS_WAR), 2048, 1024, scr, r, lane); continue; } r -= I_SQ;
        if (r < I_SQ) { transpose_item<0>(a.in[18] + (size_t)l * 1048576, 1024, (bf16*)(ws + WS_WO), 1024, 0, scr, r, lane); continue; } r -= I_SQ;
        const int e = r / (3 * I_SQ), w = (r / I_SQ) % 3, ii = r % I_SQ; const size_t eo = ((size_t)l * NEXP + e) * 1048576;
        if (w == 0) transpose_item<1>(a.in[21] + eo, 1024, (bf16*)(ws + WS_WUP) + (size_t)e * 2048 * 1024, 1024, 0, scr, ii, lane);
        else if (w == 1) transpose_item<2>(a.in[22] + eo, 1024, (bf16*)(ws + WS_WUP) + (size_t)e * 2048 * 1024, 1024, 0, scr, ii, lane);
        else transpose_item<0>(a.in[23] + eo, 1024, (bf16*)(ws + WS_WDN) + (size_t)e * 1024 * 1024, 1024, 0, scr, ii, lane);
    }
}
__device__ __forceinline__ void phase_prologue(const Args& a, LAS unsigned char* lds, int tid, int G) {
    unsigned char* ws = a.ws; float* MOD = (float*)(ws + WS_MOD);
    LAS float* sc = (LAS float*)lds;
    LAS float* red = (LAS float*)(lds + 1024 * 20 * 4);
    { float cv[34];
#pragma unroll
      for (int q = 0; q < 34; ++q) { const int i = tid + NTHREADS * q, bi = i >> 10, k = i & 1023; cv[q] = (bi < 16) ? a.in[1][bi * 1024 + k] : a.in[3][k]; }
#pragma unroll
      for (int q = 0; q < 34; ++q) { const int i = tid + NTHREADS * q, bi = i >> 10, k = i & 1023; sc[k * 20 + bi] = cv[q] * sigmoidf_(cv[q]); } }
    __syncthreads();
    const int j = tid & 63, ks = tid >> 6;
    for (int u = blockIdx.x; u < 2 * 96; u += G) {
        const int l = u / 96, col0 = (u % 96) * 64; const float* wm = a.in[4] + (size_t)l * 1024 * 6144 + col0 + j;
        float acc[17];
#pragma unroll
        for (int b = 0; b < 17; ++b) acc[b] = 0.f;
        for (int k0 = ks * 128; k0 < ks * 128 + 128; k0 += 16) { float w[16];
#pragma unroll
            for (int kk = 0; kk < 16; ++kk) w[kk] = wm[(size_t)(k0 + kk) * 6144];
#pragma unroll
            for (int kk = 0; kk < 16; ++kk)
#pragma unroll
                for (int b = 0; b < 17; ++b) acc[b] += sc[(k0 + kk) * 20 + b] * w[kk]; }
#pragma unroll
        for (int b = 0; b < 17; ++b) red[(ks * 17 + b) * 64 + j] = acc[b];
        __syncthreads();
        for (int b = ks; b < 17; b += 8) { float s = 0.f;
#pragma unroll
            for (int q = 0; q < 8; ++q) s += red[(q * 17 + b) * 64 + j];
            MOD[((size_t)l * 17 + b) * 6144 + col0 + j] = s + a.in[5][l * 6144 + col0 + j]; }
        __syncthreads();
    }
    const int gt = blockIdx.x * NTHREADS + tid, ngt = G * NTHREADS;
    float* rc = (float*)(ws + WS_ROPE); float* rs = rc + 2048 * 32;
    for (int i = gt; i < 2048 * 32; i += ngt) { const int t = i >> 5, f = i & 31; const float pos = (f < 16) ? (float)(t >> 6) : (float)(t & 63);
        const float inv = powf(10000.0f, -(float)(f & 15) / 16.0f); const float ang = pos * inv; rc[i] = cosf(ang); rs[i] = sinf(ang); }
    float* misc = (float*)(ws + WS_MISC);
    if (gt < 2) { const int l = gt; float s1 = 0.f, s2 = 0.f;
        for (int i = 0; i < 64; ++i) { s1 += a.in[9][l * 64 + i] * a.in[10][l * 64 + i]; s2 += a.in[11][l * 64 + i] * a.in[12][l * 64 + i]; }
        misc[l] = expf(s1) - expf(s2) + (0.8f - 0.6f * expf(-0.3f * (float)l)); }
    for (int i = gt; i < 1024; i += ngt) { const float a0 = a.in[14][i], a1 = a.in[14][1024 + i]; misc[256 + i] = 0.f; misc[256 + 1024 + i] = 1.0f / (1.0f + expf(a0 - a1)); }
}

struct RowRef { const float* src; float* dst; int bidx; bool lat; };
__device__ __forceinline__ RowRef row_ref(const Args& a, int l, int g, int row) {
    const int bl = row / TPB, pos = row % TPB, bgl = g * NBG + bl; RowRef r; r.lat = pos >= CTXL;
    if (r.lat) { const size_t xr = (size_t)bgl * SEQ + (pos - CTXL); r.src = ((l == 0) ? a.in[0] : a.out) + xr * 1024; r.dst = a.out + xr * 1024; r.bidx = bgl; }
    else { const size_t xr = (size_t)bgl * CTXL + pos; float* xc = (float*)(a.ws + WS_XC); r.src = ((l == 0) ? a.in[2] : xc) + xr * 1024; r.dst = xc + xr * 1024; r.bidx = 16; }
    return r;
}
__device__ __forceinline__ void norm1_rows(const Args& a, int l, int g, bf16* H, int gw, int rend, int ngw, int lane) {
    const float* MOD = (const float*)(a.ws + WS_MOD) + (size_t)l * 17 * 6144; const float* g1 = a.in[6] + l * 1024;
    f32x4 gg[4];
#pragma unroll
    for (int j = 0; j < 4; ++j) gg[j] = *(const f32x4*)(g1 + (64 * j + lane) * 4);
    f32x4 vn[4];
    if (gw < rend) { const RowRef r0 = row_ref(a, l, g, gw); const f32x4* xr = (const f32x4*)r0.src + lane;
#pragma unroll
        for (int j = 0; j < 4; ++j) vn[j] = xr[64 * j]; }
    for (int row = gw; row < rend; row += ngw) {
        const RowRef rr = row_ref(a, l, g, row);
        const float* sh = MOD + (size_t)rr.bidx * 6144; const float* scl = sh + 1024;
        f32x4 ss[4], hh[4];
#pragma unroll
        for (int j = 0; j < 4; ++j) { const int c = (64 * j + lane) * 4; ss[j] = *(const f32x4*)(scl + c); hh[j] = *(const f32x4*)(sh + c); }
        f32x4 v[4]; float s = 0.f;
#pragma unroll
        for (int j = 0; j < 4; ++j) v[j] = vn[j];
        asm volatile("" ::: "memory");
        if (row + ngw < rend) { const RowRef rn = row_ref(a, l, g, row + ngw); const f32x4* xr = (const f32x4*)rn.src + lane;
#pragma unroll
            for (int j = 0; j < 4; ++j) vn[j] = xr[64 * j]; }
#pragma unroll
        for (int j = 0; j < 4; ++j) s += (v[j].x * v[j].x + v[j].y * v[j].y) + (v[j].z * v[j].z + v[j].w * v[j].w);
        const float rstd = rsqrtf(wave_sum(s) * (1.f / D) + EPS);
        v2u* o = (v2u*)(H + (size_t)row * 1024) + lane;
#pragma unroll
        for (int j = 0; j < 4; ++j) { const f32x4 y = v[j] * rstd * gg[j] * (ss[j] + 1.0f) + hh[j]; v2u w; w.x = pk2(y.x, y.y); w.y = pk2(y.z, y.w); o[64 * j] = w; }
    }
}
__device__ __forceinline__ void phase_norm1(const Args& a, int l, int g, int gw, int ngw, int lane) { norm1_rows(a, l, g, (bf16*)(a.ws + WS_AR), gw, GT, ngw, lane); }
constexpr int FILL_ROWS = 64, FILL_UNITS = GT / FILL_ROWS;
__device__ __forceinline__ bool fill_norm1(const Args& a, int lf, int gf, volatile LAS unsigned* misc, int tid, int wave, int lane) {
    unsigned* ctr = (unsigned*)(a.ws + WS_CTL) + CW_FILL + 64 * (lf * NGRP + gf);
    for (;;) {
        __syncthreads();
        if (tid == 0) misc[1] = __hip_atomic_fetch_add(ctr, 1u, RLX_AGENT);
        __syncthreads();
        const int u = __builtin_amdgcn_readfirstlane((int)misc[1]);
        if (u >= FILL_UNITS) return true;
        norm1_rows(a, lf, gf, (bf16*)(a.ws + WS_HN), FILL_ROWS * u + wave, FILL_ROWS * u + FILL_ROWS, NWAVES, lane);
    }
}
__device__ __forceinline__ void rprep_range(unsigned char* ws_, const float* grec_in, int l, int gw, int nrows, int ngw, int lane) {
    bf16* AR = (bf16*)(ws_ + WS_AR); const bf16* OB = (const bf16*)(ws_ + WS_OB); const bf16* SRG = (const bf16*)(ws_ + WS_PROJ) + 7 * SEG_ELEMS; const float* grec = grec_in + l * 128; const int rep = 0;
    v4u fn[2], bn[2], sn[2];
#define RP_ROW(i) ((l == NLAYER - 1) ? ((i) / SEQ) * TPB + CTXL + ((i) % SEQ) : (i))
#define RP_LOAD(i) do { const int r_ = RP_ROW(i); _Pragma("unroll") for (int j = 0; j < 2; ++j) { const int c = j * 512 + lane * 8; fn[j] = *(const v4u*)(AR + (size_t)r_ * 2048 + 1024 + c); bn[j] = *(const v4u*)(OB + (size_t)r_ * 1024 + c); sn[j] = *(const v4u*)(SRG + (size_t)r_ * 1024 + c); } } while (0)
    if (gw < nrows) RP_LOAD(gw);
    for (int i = gw; i < nrows; i += ngw) {
        const int row = RP_ROW(i);
        v4u fc[2], bc[2], sc_[2];
#pragma unroll
        for (int j = 0; j < 2; ++j) { fc[j] = fn[j]; bc[j] = bn[j]; sc_[j] = sn[j]; }
        if (i + ngw < nrows) RP_LOAD(i + ngw);
#pragma unroll
        for (int j = 0; j < 2; ++j) { const int c = j * 512 + lane * 8;
            const v4u f = fc[j], b = bc[j], sg = sc_[j];
            float v[8]; v[0] = bflo(f.x) + bflo(b.x); v[1] = bfhi(f.x) + bfhi(b.x); v[2] = bflo(f.y) + bflo(b.y); v[3] = bfhi(f.y) + bfhi(b.y);
            v[4] = bflo(f.z) + bflo(b.z); v[5] = bfhi(f.z) + bfhi(b.z); v[6] = bflo(f.w) + bflo(b.w); v[7] = bfhi(f.w) + bfhi(b.w);
            float s = 0.f;
#pragma unroll
            for (int q = 0; q < 8; ++q) s += v[q] * v[q];
            s += __shfl_xor(s, 1); s += __shfl_xor(s, 2); s += __shfl_xor(s, 4); s += __shfl_xor(s, 8);
            const float rstd = rsqrtf(s * (1.f / 128.f) + EPS);
            const f32x4 g0 = *(const f32x4*)(grec + (c & 127)), g1 = *(const f32x4*)(grec + (c & 127) + 4);
            v4u w; w.x = pk2(v[0] * rstd * g0.x * bflo(sg.x), v[1] * rstd * g0.y * bfhi(sg.x)); w.y = pk2(v[2] * rstd * g0.z * bflo(sg.y), v[3] * rstd * g0.w * bfhi(sg.y));
            w.z = pk2(v[4] * rstd * g1.x * bflo(sg.z), v[5] * rstd * g1.y * bfhi(sg.z)); w.w = pk2(v[6] * rstd * g1.z * bflo(sg.w), v[7] * rstd * g1.w * bfhi(sg.w));
            *(v4u*)((rep ? (bf16*)(ws_ + WS_PROJ) : AR) + (size_t)row * 2048 + 1024 + c) = w; }
    }
#undef RP_LOAD
#undef RP_ROW
}
__device__ __forceinline__ int moe_row(int l, int i) { return (l == NLAYER - 1) ? (i / SEQ) * TPB + CTXL + (i % SEQ) : i; }
__device__ __forceinline__ int moe_nrows(int l) { return (l == NLAYER - 1) ? NBG * SEQ : GT; }
__device__ __forceinline__ void h2_load(const RowRef& rr, int lane, f32x4 (&v)[4]) {
    const f32x4* xd = (const f32x4*)rr.dst + lane;
#pragma unroll
    for (int j = 0; j < 4; ++j) v[j] = xd[64 * j];
}
struct H2Par { f32x4 ss[4], hh[4]; };
__device__ __forceinline__ void h2_params(const Args& a, int l, int bidx, int lane, H2Par& p) {
    const float* MOD = (const float*)(a.ws + WS_MOD) + (size_t)l * 17 * 6144 + (size_t)bidx * 6144;
#pragma unroll
    for (int j = 0; j < 4; ++j) { const int c = (64 * j + lane) * 4; p.ss[j] = *(const f32x4*)(MOD + 4 * 1024 + c); p.hh[j] = *(const f32x4*)(MOD + 3 * 1024 + c); }
}
__device__ __forceinline__ void h2_finish(const f32x4 (&gg)[4], const H2Par& p, f32x4 (&v)[4]) {
    float s = 0.f;
#pragma unroll
    for (int j = 0; j < 4; ++j) s += (v[j].x * v[j].x + v[j].y * v[j].y) + (v[j].z * v[j].z + v[j].w * v[j].w);
    const float rstd = rsqrtf(wave_sum(s) * (1.f / D) + EPS);
#pragma unroll
    for (int j = 0; j < 4; ++j) v[j] = v[j] * rstd * gg[j] * (p.ss[j] + 1.0f) + p.hh[j];
}
__device__ __forceinline__ void phase_route(const Args& a, int l, int g, LAS unsigned char* lds, int tid, int gw, int ngw, int lane, int rep = 0) {
    unsigned long long rp_t0 = 0, rp_acc = 0; (void)rp_t0;
#define RPB(c) do { if (PROBE_CLASS == (c)) rp_t0 = __builtin_amdgcn_s_memrealtime(); } while (0)
#define RPE(c) do { if (PROBE_CLASS == (c)) rp_acc += __builtin_amdgcn_s_memrealtime() - rp_t0; } while (0)
    RPB(14);
    LAS float* wrt = (LAS float*)lds;
    { f32x4 wv[8];
#pragma unroll
      for (int k = 0; k < 8; ++k) wv[k] = *(const f32x4*)(a.in[19] + 4 * (tid + NTHREADS * k));
#pragma unroll
      for (int k = 0; k < 8; ++k) { const int i4 = tid + NTHREADS * k, c = i4 >> 2, e0 = 4 * (i4 & 3); wrt[(e0 + 0) * 1024 + c] = wv[k].x; wrt[(e0 + 1) * 1024 + c] = wv[k].y; wrt[(e0 + 2) * 1024 + c] = wv[k].z; wrt[(e0 + 3) * 1024 + c] = wv[k].w; } }
    __syncthreads();
    unsigned* cnt = (unsigned*)(a.ws + WS_CTL) + CW_CNT + (l * NGRP + g + 4 * rep) * 16 * 64;
    const size_t dmy = rep ? (WS_DUMMY - WS_ROUTE) : 0;
    int* rte = (int*)(a.ws + WS_ROUTE + dmy + RT_E); int* rtp = (int*)(a.ws + WS_ROUTE + dmy + RT_P); float* rtw = (float*)(a.ws + WS_ROUTE + dmy + RT_W);
    bf16* h2d = (bf16*)(a.ws + (rep ? WS_DUMMY : WS_H2S)); int* list = (int*)(a.ws + WS_LIST + dmy);
    const int nrows = moe_nrows(l);
    f32x4 vn[2][4], gg2[4];
#pragma unroll
    for (int j = 0; j < 4; ++j) gg2[j] = *(const f32x4*)(a.in[7] + l * 1024 + (64 * j + lane) * 4);
    int cntv = 0, rord = 0, rec_e1 = 0, rec_e2 = 0, rec_l1 = 0, rec_l2 = 0, rec_i = 0; float rec_w1 = 0.f, rec_w2 = 0.f;
    LAS float* lgs = (LAS float*)(lds + 65536) + __builtin_amdgcn_readfirstlane(tid >> 6) * 256;
#define RT_IDX(u, i_) (((i_) + (u) * ngw < nrows) ? (i_) + (u) * ngw : (i_))
    if (gw < nrows) {
#pragma unroll
        for (int u = 0; u < 2; ++u) h2_load(row_ref(a, l, g, moe_row(l, RT_IDX(u, gw))), lane, vn[u]); }
    RPE(14); RPB(13);
    for (int i = gw; i < nrows; i += 2 * ngw) {
        H2Par hp[2]; f32x4 v[2][4]; int ii[2];
#pragma unroll
        for (int u = 0; u < 2; ++u) { ii[u] = RT_IDX(u, i); const RowRef rr = row_ref(a, l, g, moe_row(l, ii[u])); h2_params(a, l, rr.bidx, lane, hp[u]);
#pragma unroll
            for (int j = 0; j < 4; ++j) v[u][j] = vn[u][j]; }
        asm volatile("" ::: "memory");
        if (i + 2 * ngw < nrows) {
#pragma unroll
            for (int u = 0; u < 2; ++u) h2_load(row_ref(a, l, g, moe_row(l, RT_IDX(u, i + 2 * ngw))), lane, vn[u]); }
        { float s[2];
#pragma unroll
          for (int u = 0; u < 2; ++u) { s[u] = 0.f;
#pragma unroll
              for (int j = 0; j < 4; ++j) s[u] += (v[u][j].x * v[u][j].x + v[u][j].y * v[u][j].y) + (v[u][j].z * v[u][j].z + v[u][j].w * v[u][j].w); }
#pragma unroll
          for (int o = 1; o < 64; o <<= 1) {
#pragma unroll
              for (int u = 0; u < 2; ++u) s[u] += __shfl_xor(s[u], o); }
#pragma unroll
          for (int u = 0; u < 2; ++u) { const float rstd = rsqrtf(s[u] * (1.f / D) + EPS);
#pragma unroll
              for (int j = 0; j < 4; ++j) v[u][j] = v[u][j] * rstd * gg2[j] * (hp[u].ss[j] + 1.0f) + hp[u].hh[j]; } }
#pragma unroll
        for (int u = 0; u < 2; ++u) { v2u* o = (v2u*)(h2d + (size_t)ii[u] * 1024) + lane;
#pragma unroll
            for (int j = 0; j < 4; ++j) { v2u w; w.x = pk2(v[u][j].x, v[u][j].y); w.y = pk2(v[u][j].z, v[u][j].w); o[64 * j] = w; } }
        float pe[2][16];
        f32x2 vp[4][4];
#pragma unroll
        for (int j = 0; j < 4; ++j) { vp[j][0] = (f32x2){v[0][j].x, v[1][j].x}; vp[j][1] = (f32x2){v[0][j].y, v[1][j].y}; vp[j][2] = (f32x2){v[0][j].z, v[1][j].z}; vp[j][3] = (f32x2){v[0][j].w, v[1][j].w}; }
#pragma unroll
        for (int e = 0; e < 16; ++e) { f32x2 ac = {0.f, 0.f};
#pragma unroll
            for (int j = 0; j < 4; ++j) { const f32x4 w = *(const LAS f32x4*)(wrt + e * 1024 + (64 * j + lane) * 4);
                ac = __builtin_elementwise_fma(vp[j][0], (f32x2){w.x, w.x}, ac); ac = __builtin_elementwise_fma(vp[j][1], (f32x2){w.y, w.y}, ac);
                ac = __builtin_elementwise_fma(vp[j][2], (f32x2){w.z, w.z}, ac); ac = __builtin_elementwise_fma(vp[j][3], (f32x2){w.w, w.w}, ac); }
            pe[0][e] = ac.x; pe[1][e] = ac.y; if ((e & 3) == 3) asm volatile("" ::: "memory"); }
        float r8[2][8], r4[2][4], r2[2][2], r1[2];
#pragma unroll
        for (int k = 0; k < 8; ++k)
#pragma unroll
            for (int u = 0; u < 2; ++u) { const bool hi_ = (lane & 32) != 0; const float keep = hi_ ? pe[u][8 + k] : pe[u][k], send = hi_ ? pe[u][k] : pe[u][8 + k]; r8[u][k] = keep + __shfl_xor(send, 32); }
#pragma unroll
        for (int k = 0; k < 4; ++k)
#pragma unroll
            for (int u = 0; u < 2; ++u) { const bool hi_ = (lane & 16) != 0; const float keep = hi_ ? r8[u][4 + k] : r8[u][k], send = hi_ ? r8[u][k] : r8[u][4 + k]; r4[u][k] = keep + __shfl_xor(send, 16); }
#pragma unroll
        for (int k = 0; k < 2; ++k)
#pragma unroll
            for (int u = 0; u < 2; ++u) { const bool hi_ = (lane & 8) != 0; const float keep = hi_ ? r4[u][2 + k] : r4[u][k], send = hi_ ? r4[u][k] : r4[u][2 + k]; r2[u][k] = keep + __shfl_xor(send, 8); }
#pragma unroll
        for (int u = 0; u < 2; ++u) { const bool hi_ = (lane & 4) != 0; const float keep = hi_ ? r2[u][1] : r2[u][0], send = hi_ ? r2[u][0] : r2[u][1]; r1[u] = keep + __shfl_xor(send, 4); }
#pragma unroll
        for (int u = 0; u < 2; ++u) r1[u] += __shfl_xor(r1[u], 2);
#pragma unroll
        for (int u = 0; u < 2; ++u) r1[u] += __shfl_xor(r1[u], 1);
#pragma unroll
        for (int u = 0; u < 2; ++u) {
            if (u == 0 || i + ngw < nrows) {
                if ((lane & 3) == 0) lgs[rord * 16 + (lane >> 2)] = r1[u];
                if (lane == rord) rec_i = ii[u];
                ++rord;
            }
        }
    }
#undef RT_IDX
    RPE(13); RPB(15);
    asm volatile("s_waitcnt lgkmcnt(0)" ::: "memory");
    { float lg[16];
      { const LAS f32x4* lp = (const LAS f32x4*)(lgs + (lane < rord ? lane : 0) * 16);
#pragma unroll
        for (int q = 0; q < 4; ++q) { const f32x4 t4 = lp[q]; lg[4 * q] = t4.x; lg[4 * q + 1] = t4.y; lg[4 * q + 2] = t4.z; lg[4 * q + 3] = t4.w; } }
      float sc[16], bs[16];
#pragma unroll
      for (int e = 0; e < 16; ++e) { sc[e] = sigmoidf_(lg[e]); bs[e] = sc[e] + a.in[20][e]; }
      int grp = 0; float best = -1e30f;
#pragma unroll
      for (int q = 0; q < 4; ++q) { float t1 = -1e30f, t2 = -1e30f;
#pragma unroll
          for (int e = 0; e < 4; ++e) { const float x = bs[4 * q + e]; const bool gt1 = x > t1, gt2 = x > t2; t2 = gt1 ? t1 : (gt2 ? x : t2); t1 = gt1 ? x : t1; }
          const float gs = t1 + t2; const bool bt = gs > best; best = bt ? gs : best; grp = bt ? q : grp; }
      float ib[4], is[4];
#pragma unroll
      for (int e = 0; e < 4; ++e) { ib[e] = (grp == 0) ? bs[e] : (grp == 1) ? bs[4 + e] : (grp == 2) ? bs[8 + e] : bs[12 + e]; is[e] = (grp == 0) ? sc[e] : (grp == 1) ? sc[4 + e] : (grp == 2) ? sc[8 + e] : sc[12 + e]; }
      int i1 = 0; float b1 = ib[0], s1 = is[0];
#pragma unroll
      for (int e = 1; e < 4; ++e) { const bool gt = ib[e] > b1; b1 = gt ? ib[e] : b1; i1 = gt ? e : i1; s1 = gt ? is[e] : s1; }
      int i2 = -1; float b2 = -1e30f, s2 = 0.f;
#pragma unroll
      for (int e = 0; e < 4; ++e) { const bool gt = (e != i1) && (ib[e] > b2); b2 = gt ? ib[e] : b2; i2 = gt ? e : i2; s2 = gt ? is[e] : s2; }
      const float inv = 1.0f / (s1 + s2);
      rec_e1 = grp * 4 + i1; rec_e2 = grp * 4 + i2; rec_w1 = s1 * inv; rec_w2 = s2 * inv; }
    { const bool act = lane < rord; const unsigned long long lt = (1ull << lane) - 1ull;
#pragma unroll
      for (int e = 0; e < 16; ++e) { const unsigned long long mk = __ballot(act && (rec_e1 == e || rec_e2 == e)); const int before = __popcll(mk & lt);
          if (rec_e1 == e) rec_l1 = before; if (rec_e2 == e) rec_l2 = before; if (lane == e) cntv = __popcll(mk); } }
    __syncthreads();
    LAS int* cl = (LAS int*)lds;
    const int wv_ = __builtin_amdgcn_readfirstlane(tid >> 6);
    if (lane < 16) cl[wv_ * 16 + lane] = cntv;
    __syncthreads();
    if (wv_ == 0 && lane < 16) { int tot = 0;
#pragma unroll
        for (int w = 0; w < NWAVES; ++w) tot += cl[w * 16 + lane];
        int b0 = 0; if (tot > 0) b0 = (int)__hip_atomic_fetch_add(cnt + lane * 64, (unsigned)tot, RLX_AGENT);
        cl[128 + lane] = b0; }
    __syncthreads();
    int base = 0;
    if (lane < 16) { base = cl[128 + lane];
        for (int w = 0; w < wv_; ++w) base += cl[w * 16 + lane]; }
    const int b1_ = __shfl(base, rec_e1), b2_ = __shfl(base, rec_e2);
    if (lane < rord) { rte[2 * rec_i] = rec_e1; rte[2 * rec_i + 1] = rec_e2; rtp[2 * rec_i] = b1_ + rec_l1; rtp[2 * rec_i + 1] = b2_ + rec_l2; rtw[2 * rec_i] = rec_w1; rtw[2 * rec_i + 1] = rec_w2;
        list[rec_e1 * GT + b1_ + rec_l1] = rec_i; list[rec_e2 * GT + b2_ + rec_l2] = rec_i; }
    RPE(15);
    if (PROBE_CLASS >= 13 && PROBE_CLASS <= 15 && blockIdx.x == 0 && tid == 0) __hip_atomic_fetch_add((unsigned long long*)(a.ws + (size_t)CW_PROBE * 4), rp_acc, __ATOMIC_RELAXED, __HIP_MEMORY_SCOPE_AGENT);
#undef RPB
#undef RPE
}
__device__ __forceinline__ int moe_tables(const unsigned char* ws_, int l, int g, LAS unsigned char* lds, int tid) {
    const unsigned* cnt = (const unsigned*)(ws_ + WS_CTL) + CW_CNT + (l * NGRP + g) * 16 * 64;
    LAS int* tl = (LAS int*)(lds + TILE_OFF); LAS int* cn = (LAS int*)(lds + MOECN_OFF); LAS int* ex = (LAS int*)(lds + MOEEX_OFF);
    if (tid < 16) cn[tid] = (int)__hip_atomic_load(cnt + tid * 64, RLX_AGENT);
    __syncthreads();
    int incl = 0, myexp = 0;
#pragma unroll
    for (int e = 0; e < 16; ++e) { const int pc = (cn[e] + 255) & ~255; if (tid == e) ex[e] = incl; incl += pc; if (256 * tid >= incl) myexp = e + 1; }
    if (tid < 256) tl[tid] = (myexp < 16) ? myexp : 0;
    __syncthreads();
    return incl >> 8;
}
__device__ __forceinline__ void phase_combine(const Args& a, int l, int g, int gw, int ngw, int lane, int rep = 0) {
    const int* rte = (const int*)(a.ws + WS_ROUTE + RT_E); const int* rtp = (const int*)(a.ws + WS_ROUTE + RT_P); const float* rtw = (const float*)(a.ws + WS_ROUTE + RT_W); const bf16* YE = (const bf16*)(a.ws + WS_YE);
    const float* MODL = (const float*)(a.ws + WS_MOD) + (size_t)l * 17 * 6144;
    const int nrows = moe_nrows(l);
    int excl; { const unsigned* cnt = (const unsigned*)(a.ws + WS_CTL) + CW_CNT + (l * NGRP + g) * 16 * 64;
        int pc = 0; if (lane < 16) pc = ((int)__hip_atomic_load(cnt + lane * 64, RLX_AGENT) + 255) & ~255;
        int incl = pc;
#pragma unroll
        for (int o = 1; o < 16; o <<= 1) { const int t = __shfl_up(incl, o); if (lane >= o) incl += t; }
        excl = incl - pc; }
#define CB_SLOTS(i_) do { const int e1_ = ldg_i(rte + 2 * (i_)), e2_ = ldg_i(rte + 2 * (i_) + 1), p1_ = ldg_i(rtp + 2 * (i_)), p2_ = ldg_i(rtp + 2 * (i_) + 1); sn1 = __shfl(excl, e1_) + p1_; sn2 = __shfl(excl, e2_) + p2_; } while (0)
    f32x4 xn[4]; int sn1 = 0, sn2 = 0; float wn1 = 0.f, wn2 = 0.f;
    if (gw < nrows) { h2_load(row_ref(a, l, g, moe_row(l, gw)), lane, xn); CB_SLOTS(gw); wn1 = ldg_f(rtw + 2 * gw); wn2 = ldg_f(rtw + 2 * gw + 1); }
    for (int i = gw; i < nrows; i += ngw) {
        const int row = moe_row(l, i); const RowRef rr = row_ref(a, l, g, row);
        const int s1 = sn1, s2 = sn2; const float w1 = wn1, w2 = wn2;
        f32x4 xc[4];
#pragma unroll
        for (int j = 0; j < 4; ++j) xc[j] = xn[j];
        const float* gate = MODL + (size_t)rr.bidx * 6144 + 5 * 1024;
        f32x4* xd = rep ? ((f32x4*)(a.ws + WS_DUMMY) + (size_t)i * 256 + lane) : ((f32x4*)rr.dst + lane); const v2u* y1 = (const v2u*)(YE + (size_t)s1 * 1024) + lane; const v2u* y2 = (const v2u*)(YE + (size_t)s2 * 1024) + lane;
        v2u yp[4], yq[4]; f32x4 gt[4];
#pragma unroll
        for (int j = 0; j < 4; ++j) { yp[j] = y1[64 * j]; yq[j] = y2[64 * j]; gt[j] = *(const f32x4*)(gate + (64 * j + lane) * 4); }
        asm volatile("" ::: "memory");
        if (i + ngw < nrows) { const int in_ = i + ngw; h2_load(row_ref(a, l, g, moe_row(l, in_)), lane, xn); CB_SLOTS(in_); wn1 = ldg_f(rtw + 2 * in_); wn2 = ldg_f(rtw + 2 * in_ + 1); }
        f32x4 v[4]; float s = 0.f;
#pragma unroll
        for (int j = 0; j < 4; ++j) { const f32x4 x = xc[j]; const v2u p = yp[j], q = yq[j]; const f32x4 gg = gt[j];
            f32x4 y; y.x = w1 * bflo(p.x) + w2 * bflo(q.x); y.y = w1 * bfhi(p.x) + w2 * bfhi(q.x); y.z = w1 * bflo(p.y) + w2 * bflo(q.y); y.w = w1 * bfhi(p.y) + w2 * bfhi(q.y);
            v[j] = x + gg * y; s += (v[j].x * v[j].x + v[j].y * v[j].y) + (v[j].z * v[j].z + v[j].w * v[j].w); }
        if (l == NLAYER - 1) { const float rstd = rsqrtf(wave_sum(s) * (1.f / D) + EPS);
#pragma unroll
            for (int j = 0; j < 4; ++j) xd[64 * j] = v[j] * rstd * *(const f32x4*)(a.in[24] + (64 * j + lane) * 4); }
        else {
#pragma unroll
            for (int j = 0; j < 4; ++j) xd[64 * j] = v[j]; }
    }
#undef CB_SLOTS
}

__device__ __forceinline__ unsigned off_b(unsigned row, unsigned ch) { return 256u * row + 16u * (ch ^ (((row & 3u) << 2) | ((row >> 2) & 3u))); }
typedef __attribute__((address_space(3))) const unsigned char* lds_cptr;
__device__ __forceinline__ s16x4 vtr(lds_cptr p) { return __builtin_bit_cast(s16x4, __builtin_amdgcn_ds_read_tr16_b64_v4i16((__attribute__((address_space(3))) s16x4*)p)); }
__device__ __forceinline__ unsigned cvtpk(float lo, float hi) { return pk2(lo, hi); }

__device__ __forceinline__ void scan_unit(unsigned char* ws_, LAS unsigned char* lds, int tid, int bl, int h, int dir) {
    const bf16* P = (const bf16*)(ws_ + WS_PROJ);
    const bf16* RQ = P + 3 * SEG_ELEMS; const bf16* GG = P + (size_t)(4 + dir) * SEG_ELEMS; const bf16* RI = P + 6 * SEG_ELEMS;
    bf16* OUT = dir ? (bf16*)(ws_ + WS_OB) : (bf16*)(ws_ + WS_AR) + 1024; const int ldo = dir ? 1024 : 2048;
    LAS float* F = (LAS float*)lds; LAS float* KK = F + 4096; LAS float* QS = KK + 4096; LAS float* VS = QS + 4096; LAS float* OP = VS + 4096;
    const int e = tid & 127, dq = tid >> 7, sstep = tid >> 4, sch = tid & 15;
    float S[32];
#pragma unroll
    for (int i = 0; i < 32; ++i) S[i] = 0.f;
    const size_t rowbase = (size_t)bl * TPB;
    for (int tb = 0; tb < TPB / 32; ++tb) {
        { const int tau = tb * 32 + sstep; const int pos = dir ? ((tau < CTXL) ? (CTXL - 1 - tau) : (TPB - 1 - (tau - CTXL))) : tau;
          const size_t off = (rowbase + pos) * 1024 + h * 128 + sch * 8;
          const v4u gq = *(const v4u*)(GG + off), qq = *(const v4u*)(RQ + off), vv = *(const v4u*)(RI + off);
          float gv[8] = {bflo(gq.x), bfhi(gq.x), bflo(gq.y), bfhi(gq.y), bflo(gq.z), bfhi(gq.z), bflo(gq.w), bfhi(gq.w)};
          float qv[8] = {bflo(qq.x), bfhi(qq.x), bflo(qq.y), bfhi(qq.y), bflo(qq.z), bfhi(qq.z), bflo(qq.w), bfhi(qq.w)};
          float vv8[8] = {bflo(vv.x), bfhi(vv.x), bflo(vv.y), bfhi(vv.y), bflo(vv.z), bfhi(vv.z), bflo(vv.w), bfhi(vv.w)};
#pragma unroll
          for (int i = 0; i < 8; ++i) { const float f = __expf(gv[i]); F[sstep * 128 + sch * 8 + i] = f; KK[sstep * 128 + sch * 8 + i] = 1.0f - f; QS[sstep * 128 + sch * 8 + i] = qv[i]; VS[sstep * 128 + sch * 8 + i] = vv8[i]; } }
        __syncthreads();
        for (int st = 0; st < 32; ++st) {
            const float v = VS[st * 128 + e]; float acc = 0.f;
            const LAS f32x4* f4 = (const LAS f32x4*)(F + st * 128 + dq * 32); const LAS f32x4* k4 = (const LAS f32x4*)(KK + st * 128 + dq * 32); const LAS f32x4* q4 = (const LAS f32x4*)(QS + st * 128 + dq * 32);
#pragma unroll
            for (int i = 0; i < 8; ++i) { const f32x4 ff = f4[i], kk = k4[i], qq = q4[i];
                S[4 * i + 0] = ff.x * S[4 * i + 0] + kk.x * v; acc += S[4 * i + 0] * qq.x;
                S[4 * i + 1] = ff.y * S[4 * i + 1] + kk.y * v; acc += S[4 * i + 1] * qq.y;
                S[4 * i + 2] = ff.z * S[4 * i + 2] + kk.z * v; acc += S[4 * i + 2] * qq.z;
                S[4 * i + 3] = ff.w * S[4 * i + 3] + kk.w * v; acc += S[4 * i + 3] * qq.w; }
            OP[(dq * 32 + st) * 128 + e] = acc;
        }
        __syncthreads();
#pragma unroll
        for (int j = 0; j < 8; ++j) { const int st = dq + 4 * j; const float o = (OP[(0 * 32 + st) * 128 + e] + OP[(1 * 32 + st) * 128 + e]) + (OP[(2 * 32 + st) * 128 + e] + OP[(3 * 32 + st) * 128 + e]);
            const int tau = tb * 32 + st; const int pos = dir ? ((tau < CTXL) ? (CTXL - 1 - tau) : (TPB - 1 - (tau - CTXL))) : tau;
            OUT[(rowbase + pos) * ldo + h * 128 + e] = (bf16)f2bf(o); }
    }
    __syncthreads();
}

typedef float f32x4s __attribute__((ext_vector_type(4)));
__device__ __forceinline__ void scan_unit_mfma(unsigned char* ws_, LAS unsigned char* lds, int tid, int l, int bl, int h, int dir) {
    const bf16* PJ = (const bf16*)(ws_ + WS_PROJ);
    const bf16* RQ = PJ + 3 * SEG_ELEMS; const bf16* GG = PJ + (size_t)(4 + dir) * SEG_ELEMS; const bf16* RI = PJ + 6 * SEG_ELEMS;
    bf16* OUT = dir ? (bf16*)(ws_ + WS_OB) : (bf16*)(ws_ + WS_AR) + 1024; const int ldo = dir ? 1024 : 2048;
    LAS unsigned char* QT = lds; LAS unsigned char* KT = lds + 16384; LAS unsigned char* KH = lds + 32768; LAS unsigned char* VT = lds + 49152; LAS unsigned char* PL = lds + 65536;
    LAS float* TOT = (LAS float*)(lds + 73728); LAS float* EGM = TOT + 1024; LAS float* EGE = EGM + 128;
    const int lane = tid & 63, wid = __builtin_amdgcn_readfirstlane(tid >> 6), l15 = lane & 15, g4 = lane >> 4;
    const int dp = lane, tg = wid;
    const size_t rowbase = (size_t)bl * TPB; const size_t colo = (size_t)h * 128 + 2 * dp;
    f32x4 S[8];
#pragma unroll
    for (int i = 0; i < 8; ++i) S[i] = (f32x4){0.f, 0.f, 0.f, 0.f};
    unsigned gr_[8], qr_[8], vr_[8];
#define SCAN_POS(tau) (dir ? (((tau) < CTXL) ? (CTXL - 1 - (tau)) : (TPB - 1 - ((tau) - CTXL))) : (tau))
#define SCAN_LOAD(c) do { _Pragma("unroll") for (int i = 0; i < 8; ++i) { const int tau = 64 * (c) + 8 * tg + i; const size_t off = (rowbase + SCAN_POS(tau)) * 1024 + colo; gr_[i] = *(const unsigned*)(GG + off); qr_[i] = *(const unsigned*)(RQ + off); vr_[i] = *(const unsigned*)(RI + off); } } while (0)
    SCAN_LOAD(0);
    for (int c = 0; c < TPB / 64; ++c) {
        const bool need_o = !(l == NLAYER - 1 && c < CTXL / 64);
        float cs0[8], cs1[8]; float run0 = 0.f, run1 = 0.f;
#pragma unroll
        for (int i = 0; i < 8; ++i) { run0 += bflo(gr_[i]); run1 += bfhi(gr_[i]); cs0[i] = run0; cs1[i] = run1; }
        *(LAS f32x2*)(TOT + tg * 128 + 2 * dp) = (f32x2){run0, run1};
        __syncthreads();
        float of0 = 0.f, of1 = 0.f, gm0 = 0.f, gm1 = 0.f, ge0 = 0.f, ge1 = 0.f;
#pragma unroll
        for (int q = 0; q < 8; ++q) { const f32x2 tv = *(const LAS f32x2*)(TOT + q * 128 + 2 * dp); if (q < tg) { of0 += tv.x; of1 += tv.y; } if (q < 4) { gm0 += tv.x; gm1 += tv.y; } ge0 += tv.x; ge1 += tv.y; }
        if (tg == 0) { *(LAS f32x2*)(EGM + 2 * dp) = (f32x2){__expf(gm0), __expf(gm1)}; *(LAS f32x2*)(EGE + 2 * dp) = (f32x2){__expf(ge0), __expf(ge1)}; }
        const float egd0 = __expf(ge0 - gm0), egd1 = __expf(ge1 - gm1);
        unsigned kh0[4], kh1[4], vt0[4], vt1[4];
#pragma unroll
        for (int i = 0; i < 8; i += 2) {
            float a0[2], a1[2];
#pragma unroll
            for (int q = 0; q < 2; ++q) { const int ii = i + q, t = 8 * tg + ii; const float G0 = of0 + cs0[ii], G1 = of1 + cs1[ii];
                const float k0 = 1.0f - __expf(bflo(gr_[ii])), k1 = 1.0f - __expf(bfhi(gr_[ii]));
                const float q0 = bflo(qr_[ii]) * __expf(G0 - gm0), q1 = bfhi(qr_[ii]) * __expf(G1 - gm1);
                const float kt0 = k0 * __expf(gm0 - G0), kt1 = k1 * __expf(gm1 - G1); a0[q] = kt0 * egd0; a1[q] = kt1 * egd1;
                const unsigned so = t * 256 + 16 * ((unsigned)(dp >> 2) ^ (unsigned)(t & 15)) + 4 * (dp & 3);
                *(LAS unsigned*)(QT + so) = pk2(q0, q1); *(LAS unsigned*)(KT + so) = pk2(kt0, kt1); }
            kh0[i >> 1] = pk2(a0[0], a0[1]); kh1[i >> 1] = pk2(a1[0], a1[1]);
            vt0[i >> 1] = (vr_[i] & 0xffffu) | (vr_[i + 1] << 16); vt1[i >> 1] = (vr_[i] >> 16) | (vr_[i + 1] & 0xffff0000u);
        }
        { const unsigned d0_ = 2 * dp, d1_ = 2 * dp + 1; const unsigned o0 = d0_ * 128 + 16 * ((unsigned)tg ^ (d0_ & 7)), o1 = d1_ * 128 + 16 * ((unsigned)tg ^ (d1_ & 7));
          *(LAS v4u*)(KH + o0) = (v4u){kh0[0], kh0[1], kh0[2], kh0[3]}; *(LAS v4u*)(KH + o1) = (v4u){kh1[0], kh1[1], kh1[2], kh1[3]};
          *(LAS v4u*)(VT + o0) = (v4u){vt0[0], vt0[1], vt0[2], vt0[3]}; *(LAS v4u*)(VT + o1) = (v4u){vt1[0], vt1[1], vt1[2], vt1[3]}; }
        __syncthreads();
        if (c + 1 < TPB / 64) SCAN_LOAD(c + 1);
        f32x4 acc[4];
#pragma unroll
        for (int i = 0; i < 4; ++i) acc[i] = (f32x4){0.f, 0.f, 0.f, 0.f};
        if (need_o) {
            const int ti = wid >> 1;
#pragma unroll
            for (int jj = 0; jj < 2; ++jj) { const int sj = 2 * (wid & 1) + jj; f32x4 sc = {0.f, 0.f, 0.f, 0.f};
                if (sj <= ti) { const int ra = 16 * ti + l15, rb = 16 * sj + l15;
#pragma unroll
                    for (int ks = 0; ks < 4; ++ks) { const bf16x8 av = *(const LAS bf16x8*)(QT + ra * 256 + 16 * ((4 * ks + g4) ^ (ra & 15))), bv = *(const LAS bf16x8*)(KT + rb * 256 + 16 * ((4 * ks + g4) ^ (rb & 15)));
                        sc = __builtin_amdgcn_mfma_f32_16x16x32_bf16(av, bv, sc, 0, 0, 0); } }
                const int s = 16 * sj + l15;
#pragma unroll
                for (int r = 0; r < 4; ++r) { const int t = 16 * ti + 4 * g4 + r; const float v = (s <= t) ? sc[r] : 0.f;
                    *(LAS unsigned short*)(PL + t * 128 + 16 * ((s >> 3) ^ (t & 7)) + 2 * (s & 7)) = (unsigned short)f2bf(v); } }
            bf16x8 sb[4];
#pragma unroll
            for (int ks = 0; ks < 4; ++ks) { const f32x4 e0 = *(const LAS f32x4*)(EGM + 32 * ks + 4 * g4), e1 = *(const LAS f32x4*)(EGM + 32 * ks + 16 + 4 * g4); const f32x4 x0 = S[2 * ks] * e0, x1 = S[2 * ks + 1] * e1;
                v4u w; w.x = pk2(x0[0], x0[1]); w.y = pk2(x0[2], x0[3]); w.z = pk2(x1[0], x1[1]); w.w = pk2(x1[2], x1[3]); sb[ks] = __builtin_bit_cast(bf16x8, w); }
#pragma unroll
            for (int i = 0; i < 4; ++i) { const int ra = 16 * i + l15;
#pragma unroll
                for (int ks = 0; ks < 4; ++ks) { const v2u lo = *(const LAS v2u*)(QT + ra * 256 + 16 * ((4 * ks + (g4 >> 1)) ^ (ra & 15)) + 8 * (g4 & 1)), hi = *(const LAS v2u*)(QT + ra * 256 + 16 * ((4 * ks + 2 + (g4 >> 1)) ^ (ra & 15)) + 8 * (g4 & 1));
                    const v4u w = {lo.x, lo.y, hi.x, hi.y}; acc[i] = __builtin_amdgcn_mfma_f32_16x16x32_bf16(__builtin_bit_cast(bf16x8, w), sb[ks], acc[i], 0, 0, 0); } }
        }
        __syncthreads();
        bf16x8 vt[2];
        { const int re = 16 * wid + l15;
#pragma unroll
          for (int ks = 0; ks < 2; ++ks) vt[ks] = *(const LAS bf16x8*)(VT + re * 128 + 16 * ((4 * ks + g4) ^ (re & 7))); }
        if (need_o) {
#pragma unroll
            for (int i = 0; i < 4; ++i) { const int ra = 16 * i + l15;
#pragma unroll
                for (int ks = 0; ks < 2; ++ks) { const bf16x8 pv = *(const LAS bf16x8*)(PL + ra * 128 + 16 * ((4 * ks + g4) ^ (ra & 7))); acc[i] = __builtin_amdgcn_mfma_f32_16x16x32_bf16(pv, vt[ks], acc[i], 0, 0, 0); } }
#pragma unroll
            for (int i = 0; i < 4; ++i)
#pragma unroll
                for (int r = 0; r < 4; ++r) { const int tau = 64 * c + 16 * i + 4 * g4 + r; OUT[(rowbase + SCAN_POS(tau)) * ldo + h * 128 + 16 * wid + l15] = (bf16)f2bf(acc[i][r]); }
        }
#pragma unroll
        for (int db = 0; db < 8; ++db) { const f32x4 eg = *(const LAS f32x4*)(EGE + 16 * db + 4 * g4); S[db] = S[db] * eg; const int rd = 16 * db + l15;
#pragma unroll
            for (int ks = 0; ks < 2; ++ks) { const bf16x8 kv = *(const LAS bf16x8*)(KH + rd * 128 + 16 * ((4 * ks + g4) ^ (rd & 7))); S[db] = __builtin_amdgcn_mfma_f32_16x16x32_bf16(kv, vt[ks], S[db], 0, 0, 0); } }
        __syncthreads();
    }
#undef SCAN_LOAD
#undef SCAN_POS
}

__device__ __forceinline__ void scan_unit_pipe(unsigned char* ws_, LAS unsigned char* lds, int tid, int l, int bl, int h, int dir) {
    const bf16* PJ = (const bf16*)(ws_ + WS_PROJ);
    const bf16* RQ = PJ + 3 * SEG_ELEMS; const bf16* GG = PJ + (size_t)(4 + dir) * SEG_ELEMS; const bf16* RI = PJ + 6 * SEG_ELEMS;
    bf16* OUT = dir ? (bf16*)(ws_ + WS_OB) : (bf16*)(ws_ + WS_AR) + 1024; const int ldo = dir ? 1024 : 2048;
    LAS unsigned char* PL = lds + 131072; LAS float* TOT = (LAS float*)(lds + 139264); LAS float* EG = (LAS float*)(lds + 143360);
    const int lane = tid & 63, wid = __builtin_amdgcn_readfirstlane(tid >> 6), l15 = lane & 15, g4 = lane >> 4;
    const int dp = lane, tg = wid;
    const size_t rowbase = (size_t)bl * TPB; const size_t colo = (size_t)h * 128 + 2 * dp;
    constexpr int NCH = TPB / 64;
    f32x4 S[8];
#pragma unroll
    for (int i = 0; i < 8; ++i) S[i] = (f32x4){0.f, 0.f, 0.f, 0.f};
    unsigned gr_[8], qr_[8], vr_[8], gn_[8];
#define SCAN_POS(tau) (dir ? (((tau) < CTXL) ? (CTXL - 1 - (tau)) : (TPB - 1 - ((tau) - CTXL))) : (tau))
#define SCAN_LOADN(c) do { _Pragma("unroll") for (int i = 0; i < 8; ++i) { const int tau = 64 * (c) + 8 * tg + i; const size_t off = (rowbase + SCAN_POS(tau)) * 1024 + colo; gn_[i] = *(const unsigned*)(GG + off); } } while (0)
#define SCAN_LOADQV(c) do { _Pragma("unroll") for (int i = 0; i < 8; ++i) { const int tau = 64 * (c) + 8 * tg + i; const size_t off = (rowbase + SCAN_POS(tau)) * 1024 + colo; qr_[i] = *(const unsigned*)(RQ + off); vr_[i] = *(const unsigned*)(RI + off); } } while (0)
#define SCAN_LOAD(c) do { _Pragma("unroll") for (int i = 0; i < 8; ++i) { const int tau = 64 * (c) + 8 * tg + i; const size_t off = (rowbase + SCAN_POS(tau)) * 1024 + colo; gr_[i] = *(const unsigned*)(GG + off); qr_[i] = *(const unsigned*)(RQ + off); vr_[i] = *(const unsigned*)(RI + off); } } while (0)
#define SCAN_PREP1() do { float run0 = 0.f, run1 = 0.f; _Pragma("unroll") for (int i = 0; i < 8; ++i) { run0 += bflo(gr_[i]); run1 += bfhi(gr_[i]); } \
        *(LAS f32x2*)(TOT + tg * 128 + 2 * dp) = (f32x2){run0, run1}; } while (0)
#define SCAN_PREP2(so_, egs_) do { LAS unsigned char* QT_ = lds + (so_); LAS unsigned char* KT_ = QT_ + 16384; LAS unsigned char* KH_ = QT_ + 32768; LAS unsigned char* VT_ = QT_ + 49152; \
        float of0 = 0.f, of1 = 0.f, gm0 = 0.f, gm1 = 0.f, ge0 = 0.f, ge1 = 0.f; \
        _Pragma("unroll") for (int q = 0; q < 8; ++q) { const f32x2 tv = *(const LAS f32x2*)(TOT + q * 128 + 2 * dp); if (q < tg) { of0 += tv.x; of1 += tv.y; } if (q < 4) { gm0 += tv.x; gm1 += tv.y; } ge0 += tv.x; ge1 += tv.y; } \
        if (tg == 0) { *(LAS f32x2*)((egs_) + 2 * dp) = (f32x2){__expf(gm0), __expf(gm1)}; *(LAS f32x2*)((egs_) + 128 + 2 * dp) = (f32x2){__expf(ge0), __expf(ge1)}; } \
        const float egd0 = __expf(ge0 - gm0), egd1 = __expf(ge1 - gm1); \
        float E0 = __expf(of0 - gm0), E1 = __expf(of1 - gm1);     \
        unsigned kh0[4], kh1[4], vt0[4], vt1[4]; \
        _Pragma("unroll") for (int i = 0; i < 8; i += 2) { float a0[2], a1[2]; \
            _Pragma("unroll") for (int q = 0; q < 2; ++q) { const int ii = i + q, t = 8 * tg + ii; \
                const float f0 = __expf(bflo(gr_[ii])), f1 = __expf(bfhi(gr_[ii])); E0 *= f0; E1 *= f1; const float k0 = 1.0f - f0, k1 = 1.0f - f1; \
                const float q0 = bflo(qr_[ii]) * E0, q1 = bfhi(qr_[ii]) * E1; \
                const float kt0 = k0 * __builtin_amdgcn_rcpf(E0), kt1 = k1 * __builtin_amdgcn_rcpf(E1); a0[q] = kt0 * egd0; a1[q] = kt1 * egd1; \
                const unsigned so = t * 256 + 16 * ((unsigned)(dp >> 2) ^ (unsigned)(t & 15)) + 4 * (dp & 3); \
                *(LAS unsigned*)(QT_ + so) = pk2(q0, q1); *(LAS unsigned*)(KT_ + so) = pk2(kt0, kt1); } \
            kh0[i >> 1] = pk2(a0[0], a0[1]); kh1[i >> 1] = pk2(a1[0], a1[1]); \
            vt0[i >> 1] = (vr_[i] & 0xffffu) | (vr_[i + 1] << 16); vt1[i >> 1] = (vr_[i] >> 16) | (vr_[i + 1] & 0xffff0000u); } \
        { const unsigned d0_ = 2 * dp, d1_ = 2 * dp + 1; const unsigned o0 = d0_ * 128 + 16 * ((unsigned)tg ^ (d0_ & 7)), o1 = d1_ * 128 + 16 * ((unsigned)tg ^ (d1_ & 7)); \
          *(LAS v4u*)(KH_ + o0) = (v4u){kh0[0], kh0[1], kh0[2], kh0[3]}; *(LAS v4u*)(KH_ + o1) = (v4u){kh1[0], kh1[1], kh1[2], kh1[3]}; \
          *(LAS v4u*)(VT_ + o0) = (v4u){vt0[0], vt0[1], vt0[2], vt0[3]}; *(LAS v4u*)(VT_ + o1) = (v4u){vt1[0], vt1[1], vt1[2], vt1[3]}; } } while (0)
    SCAN_LOAD(0); SCAN_LOADN(1); SCAN_PREP1(); __syncthreads(); SCAN_PREP2(0u, EG); SCAN_LOADQV(1);
#pragma unroll
    for (int i = 0; i < 8; ++i) gr_[i] = gn_[i];
    __syncthreads();
    for (int c = 0; c < NCH; ++c) {
        const unsigned cur = (unsigned)(c & 1) * 65536u, nxt = 65536u - cur;
        const LAS unsigned char* QT = lds + cur; const LAS unsigned char* KT = QT + 16384; const LAS unsigned char* KH = QT + 32768; const LAS unsigned char* VT = QT + 49152;
        const LAS float* EGM = EG + (c & 1) * 256; const LAS float* EGE = EGM + 128; LAS float* EGN = EG + ((c & 1) ^ 1) * 256;
        const bool need_o = !(l == NLAYER - 1 && c < CTXL / 64);
        { const int cn = (c + 2 < NCH) ? c + 2 : NCH - 1; SCAN_LOADN(cn); }
        SCAN_PREP1();
        f32x4 acc[4];
#pragma unroll
        for (int i = 0; i < 4; ++i) acc[i] = (f32x4){0.f, 0.f, 0.f, 0.f};
        { const int ti = wid >> 1;
#pragma unroll
          for (int jj = 0; jj < 2; ++jj) { const int sj = 2 * (wid & 1) + jj; f32x4 sc = {0.f, 0.f, 0.f, 0.f};
              if (sj <= ti) { const int ra = 16 * ti + l15, rb = 16 * sj + l15;
#pragma unroll
                  for (int ks = 0; ks < 4; ++ks) { const bf16x8 av = *(const LAS bf16x8*)(QT + ra * 256 + 16 * ((4 * ks + g4) ^ (ra & 15))), bv = *(const LAS bf16x8*)(KT + rb * 256 + 16 * ((4 * ks + g4) ^ (rb & 15)));
                      sc = __builtin_amdgcn_mfma_f32_16x16x32_bf16(av, bv, sc, 0, 0, 0); } }
              const int s = 16 * sj + l15;
#pragma unroll
              for (int r = 0; r < 4; ++r) { const int t = 16 * ti + 4 * g4 + r; const float v = (s <= t) ? sc[r] : 0.f;
                  *(LAS unsigned short*)(PL + t * 128 + 16 * ((s >> 3) ^ (t & 7)) + 2 * (s & 7)) = (unsigned short)(pk2(v, 0.f) & 0xffffu); } }
          bf16x8 sb[4];
#pragma unroll
          for (int ks = 0; ks < 4; ++ks) { const f32x4 e0 = *(const LAS f32x4*)(EGM + 32 * ks + 4 * g4), e1 = *(const LAS f32x4*)(EGM + 32 * ks + 16 + 4 * g4); const f32x4 x0 = S[2 * ks] * e0, x1 = S[2 * ks + 1] * e1;
              v4u w; w.x = pk2(x0[0], x0[1]); w.y = pk2(x0[2], x0[3]); w.z = pk2(x1[0], x1[1]); w.w = pk2(x1[2], x1[3]); sb[ks] = __builtin_bit_cast(bf16x8, w); }
#pragma unroll
          for (int i = 0; i < 4; ++i) { const int ra = 16 * i + l15;
#pragma unroll
              for (int ks = 0; ks < 4; ++ks) { const v2u lo = *(const LAS v2u*)(QT + ra * 256 + 16 * ((4 * ks + (g4 >> 1)) ^ (ra & 15)) + 8 * (g4 & 1)), hi = *(const LAS v2u*)(QT + ra * 256 + 16 * ((4 * ks + 2 + (g4 >> 1)) ^ (ra & 15)) + 8 * (g4 & 1));
                  const v4u w = {lo.x, lo.y, hi.x, hi.y}; acc[i] = __builtin_amdgcn_mfma_f32_16x16x32_bf16(__builtin_bit_cast(bf16x8, w), sb[ks], acc[i], 0, 0, 0); } } }
        __syncthreads();
        SCAN_PREP2(nxt, EGN);
        { const int cq = (c + 2 < NCH) ? c + 2 : NCH - 1; SCAN_LOADQV(cq); }
        bf16x8 vt[2];
        { const int re = 16 * wid + l15;
#pragma unroll
          for (int ks = 0; ks < 2; ++ks) vt[ks] = *(const LAS bf16x8*)(VT + re * 128 + 16 * ((4 * ks + g4) ^ (re & 7))); }
#pragma unroll
        for (int i = 0; i < 4; ++i) { const int ra = 16 * i + l15;
#pragma unroll
            for (int ks = 0; ks < 2; ++ks) { const bf16x8 pv = *(const LAS bf16x8*)(PL + ra * 128 + 16 * ((4 * ks + g4) ^ (ra & 7))); acc[i] = __builtin_amdgcn_mfma_f32_16x16x32_bf16(pv, vt[ks], acc[i], 0, 0, 0); } }
        if (need_o) {
            LAS unsigned char* ot = lds + cur + wid * 2048;
#pragma unroll
            for (int i = 0; i < 4; ++i)
#pragma unroll
                for (int r = 0; r < 4; ++r) *(LAS unsigned short*)(ot + (16 * i + 4 * g4 + r) * 32 + 2 * l15) = (unsigned short)(pk2(acc[i][r], 0.f) & 0xffffu);
            asm volatile("s_waitcnt lgkmcnt(0)" ::: "memory");
            const v4u o0 = *(const LAS v4u*)(ot + lane * 32), o1 = *(const LAS v4u*)(ot + lane * 32 + 16);
            const int tau = 64 * c + lane; bf16* op = OUT + (rowbase + SCAN_POS(tau)) * ldo + h * 128 + 16 * wid;
            *(v4u*)op = o0; *(v4u*)(op + 8) = o1;
        }
#pragma unroll
        for (int db = 0; db < 8; ++db) { const f32x4 eg = *(const LAS f32x4*)(EGE + 16 * db + 4 * g4); S[db] = S[db] * eg; const int rd = 16 * db + l15;
#pragma unroll
            for (int ks = 0; ks < 2; ++ks) { const bf16x8 kv = *(const LAS bf16x8*)(KH + rd * 128 + 16 * ((4 * ks + g4) ^ (rd & 7))); S[db] = __builtin_amdgcn_mfma_f32_16x16x32_bf16(kv, vt[ks], S[db], 0, 0, 0); } }
#pragma unroll
        for (int i = 0; i < 8; ++i) gr_[i] = gn_[i];
        __syncthreads();
    }
#undef SCAN_LOAD
#undef SCAN_LOADN
#undef SCAN_LOADQV
#undef SCAN_POS
#undef SCAN_PREP1
#undef SCAN_PREP2
}

#define ATT_BIG 1.0995116e12f
#ifndef REP_ATTN
#define REP_ATTN 1
#endif
#ifndef REP_SCAN
#define REP_SCAN 1
#endif
#ifndef SCAN_MFMA
#define SCAN_MFMA 2
#endif
__device__ __forceinline__ int attn_unit(unsigned char* ws_, const float* gsub, LAS unsigned char* lds, int tid, int l, int bl, int h, int qb, unsigned* head, volatile LAS unsigned* misc) {
    const bf16* P = (const bf16*)(ws_ + WS_PROJ);
    const bf16* Q = P; const bf16* K = P + SEG_ELEMS; const bf16* V = P + 2 * SEG_ELEMS; bf16* AR = (bf16*)(ws_ + WS_AR);
    asm volatile("" : "+v"(tid));
    const int lane = tid & 63, wid = __builtin_amdgcn_readfirstlane(tid >> 6), r32 = lane & 31, hi = lane >> 5, mp = wid >> 2, qs = wid & 3;
    unsigned long long tp_acc = 0, tp_0 = 0;
#define ATP_START(c, w) do { if (PROBE_CLASS == (c) && wid == (w)) tp_0 = __builtin_amdgcn_s_memrealtime(); } while (0)
#define ATP_STOP(c, w) do { if (PROBE_CLASS == (c) && wid == (w)) tp_acc += __builtin_amdgcn_s_memrealtime() - tp_0; } while (0)
    ATP_START(26, 0); ATP_START(28, 0);
    const size_t rowbase = (size_t)bl * TPB; const int nkt = (qb < 2) ? (CTXL / 64) : (TPB / 64);
    const size_t qrow = rowbase + 128 * qb + 32 * qs + r32;
    bf16x8 qr[4];
#pragma unroll
    for (int d0 = 0; d0 < 4; ++d0) qr[d0] = *(const bf16x8*)(Q + qrow * 1024 + h * 128 + mp * 64 + d0 * 16 + hi * 8);
    const int srow = 4 * wid + (lane >> 4), pch = lane & 15;
    const unsigned ssw = ((srow & 3) << 2) | ((srow >> 2) & 3);
    const bf16* Kg = K + (rowbase + srow) * 1024 + h * 128 + ((unsigned)pch ^ ssw) * 8; const bf16* Vg = V + (rowbase + srow) * 1024 + h * 128 + ((unsigned)pch ^ ssw) * 8;
    const unsigned dw = (unsigned)wid * 1024u;
    const unsigned ldsb = (unsigned)(uintptr_t)lds + dw;
#define ATT_DMA1(gp, la_) do { unsigned keep_; asm volatile("s_mov_b32 %0, m0\n\ts_mov_b32 m0, %2\n\ts_nop 0\n\tglobal_load_lds_dwordx4 %1, off\n\ts_mov_b32 m0, %0" : "=&s"(keep_) : "v"(gp), "s"((unsigned)__builtin_amdgcn_readfirstlane(la_)) : "memory"); } while (0)
#define ATT_DMA_K(t) do { const unsigned b_ = ldsb + (unsigned)(((t) & 3) * 16384); ATT_DMA1(Kg + (size_t)(64 * (t)) * 1024, b_); ATT_DMA1(Kg + (size_t)(64 * (t) + 32) * 1024, b_ + 8192); } while (0)
#define ATT_DMA_V(t, slot_) do { const unsigned b_ = ldsb + 65536u + (unsigned)((slot_) * 16384); ATT_DMA1(Vg + (size_t)(64 * (t)) * 1024, b_); ATT_DMA1(Vg + (size_t)(64 * (t) + 32) * 1024, b_ + 8192); } while (0)
#define ATT_DMA_WAIT() asm volatile("s_waitcnt vmcnt(0)" ::: "memory")
    f32x16 o[4];
#pragma unroll
    for (int c = 0; c < 4; ++c)
#pragma unroll
        for (int r = 0; r < 16; ++r) o[c][r] = 0.f;
    float m_run, l_run;
    const int q4 = (lane & 15) >> 2, blk = (lane >> 4) & 1, pp = lane & 3;
    unsigned kbo[4], vbo[4][2];
    { const unsigned swk = ((r32 & 3) << 2) | ((r32 >> 2) & 3);
#pragma unroll
      for (int d0 = 0; d0 < 4; ++d0) kbo[d0] = 256u * r32 + 16u * ((unsigned)(mp * 8 + 2 * d0 + hi) ^ swk);
#pragma unroll
      for (int c = 0; c < 4; ++c)
#pragma unroll
          for (int x = 0; x < 2; ++x) vbo[c][x] = 2048u * x + 1024u * hi + 256u * q4 + 64u * ((unsigned)c ^ (unsigned)q4) + 16u * ((unsigned)(2 * blk + (pp >> 1)) ^ (unsigned)(2 * x + hi)) + 8u * (pp & 1); }
#define ATT_QK(Kb_) do { _Pragma("unroll") for (int r = 0; r < 16; ++r) { p0[r] = 0.f; p1[r] = 0.f; } \
        _Pragma("unroll") for (int d0 = 0; d0 < 4; ++d0) { const bf16x8 a0 = *(const LAS bf16x8*)((Kb_) + kbo[d0]), a1 = *(const LAS bf16x8*)((Kb_) + kbo[d0] + 8192); \
            p0 = __builtin_amdgcn_mfma_f32_32x32x16_bf16(a0, qr[d0], p0, 0, 0, 0); p1 = __builtin_amdgcn_mfma_f32_32x32x16_bf16(a1, qr[d0], p1, 0, 0, 0); } } while (0)
#define ATT_MAX3(a_, b_, c_) __builtin_fmaxf(__builtin_fmaxf((a_), (b_)), (c_))
#define ATT_ROWMAX(mx_) do { float a_ = ATT_MAX3(p0[0], p0[1], p1[0]), b_ = ATT_MAX3(p0[2], p0[3], p1[1]); a_ = ATT_MAX3(a_, p1[2], p1[3]); \
        _Pragma("unroll") for (int r = 4; r < 16; r += 4) { a_ = ATT_MAX3(a_, p0[r], p0[r + 1]); b_ = ATT_MAX3(b_, p0[r + 2], p0[r + 3]); a_ = ATT_MAX3(a_, p1[r], p1[r + 1]); b_ = ATT_MAX3(b_, p1[r + 2], p1[r + 3]); } \
        const float m_ = __builtin_fmaxf(a_, b_); const auto rr_ = __builtin_amdgcn_permlane32_swap(__float_as_uint(m_), __float_as_uint(m_), false, false); \
        mx_ = __builtin_fmaxf(__uint_as_float(rr_[0]), __uint_as_float(rr_[1])); } while (0)
#define ATT_PVSTEP(Vb_, c, s) do { const s16x4 lo_ = vtr((lds_cptr)((Vb_) + vbo[c][0] + 4096 * (s))), hh_ = vtr((lds_cptr)((Vb_) + vbo[c][1] + 4096 * (s))); \
        const bf16x8 va_ = {lo_[0], lo_[1], lo_[2], lo_[3], hh_[0], hh_[1], hh_[2], hh_[3]}; o[c] = __builtin_amdgcn_mfma_f32_32x32x16_bf16(va_, __builtin_bit_cast(bf16x8, pw[s]), o[c], 0, 0, 0); } while (0)
    f32x16 p0, p1; v4u pw[4];
    ATT_DMA_K(0); ATT_DMA_K(1); ATT_DMA_V(0, 0); ATT_DMA_WAIT(); __syncthreads();
    ATT_DMA_K(2); ATT_DMA_K(3); ATT_DMA_V(1, 1); ATT_DMA_V(2, 2);
    { const LAS unsigned char* Kb = lds; ATT_QK(Kb); float mx; ATT_ROWMAX(mx); m_run = bflo(pk2(mx, 0.f)); float ls = 0.f;
#pragma unroll
      for (int r = 0; r < 16; ++r) { p0[r] = __builtin_amdgcn_exp2f(p0[r] - m_run); p1[r] = __builtin_amdgcn_exp2f(p1[r] - m_run); ls += p0[r] + p1[r]; }
      l_run = ls;
      pw[0] = (v4u){cvtpk(p0[0], p0[1]), cvtpk(p0[2], p0[3]), cvtpk(p0[4], p0[5]), cvtpk(p0[6], p0[7])}; pw[1] = (v4u){cvtpk(p0[8], p0[9]), cvtpk(p0[10], p0[11]), cvtpk(p0[12], p0[13]), cvtpk(p0[14], p0[15])};
      pw[2] = (v4u){cvtpk(p1[0], p1[1]), cvtpk(p1[2], p1[3]), cvtpk(p1[4], p1[5]), cvtpk(p1[6], p1[7])}; pw[3] = (v4u){cvtpk(p1[8], p1[9]), cvtpk(p1[10], p1[11]), cvtpk(p1[12], p1[13]), cvtpk(p1[14], p1[15])}; }
#define ATT_VLOAD(dst, Vb_, c, sh) do { dst[0] = vtr((lds_cptr)((Vb_) + vbo[c][0] + 4096 * (2 * (sh)))); dst[1] = vtr((lds_cptr)((Vb_) + vbo[c][1] + 4096 * (2 * (sh)))); \
        dst[2] = vtr((lds_cptr)((Vb_) + vbo[c][0] + 4096 * (2 * (sh) + 1))); dst[3] = vtr((lds_cptr)((Vb_) + vbo[c][1] + 4096 * (2 * (sh) + 1))); } while (0)
#define ATT_PV1(src, c, s) do { const bf16x8 va_ = {src[2 * ((s) & 1)][0], src[2 * ((s) & 1)][1], src[2 * ((s) & 1)][2], src[2 * ((s) & 1)][3], src[2 * ((s) & 1) + 1][0], src[2 * ((s) & 1) + 1][1], src[2 * ((s) & 1) + 1][2], src[2 * ((s) & 1) + 1][3]}; \
        o[c] = __builtin_amdgcn_mfma_f32_32x32x16_bf16(va_, __builtin_bit_cast(bf16x8, pw[s]), o[c], 0, 0, 0); } while (0)
#define ATT_EXP2(E, P, r) asm volatile("v_exp_f32 %0, %3\n\tv_exp_f32 %1, %4\n\tv_add_f32 %2, %2, %0\n\tv_add_f32 %2, %2, %1" : "=&v"(E[r]), "=&v"(E[(r) + 1]), "+v"(ls) : "v"(P[r]), "v"(P[(r) + 1]))
#define ATT_EXP4(E, P, r) asm volatile("v_exp_f32 %0, %5\n\tv_exp_f32 %1, %6\n\tv_exp_f32 %2, %7\n\tv_exp_f32 %3, %8\n\tv_add_f32 %4, %4, %0\n\tv_add_f32 %4, %4, %1\n\tv_add_f32 %4, %4, %2\n\tv_add_f32 %4, %4, %3" : "=&v"(E[r]), "=&v"(E[(r) + 1]), "=&v"(E[(r) + 2]), "=&v"(E[(r) + 3]), "+v"(ls) : "v"(P[r]), "v"(P[(r) + 1]), "v"(P[(r) + 2]), "v"(P[(r) + 3]))
#define ATT_SB() __builtin_amdgcn_sched_barrier(0)
    ATP_STOP(28, 0); ATP_START(21, 0);
    int vs = 0;
    v4u kaug = {(hi == 0) ? 0x3f80u : 0u, 0u, 0u, 0u}, qaug = {(hi == 0) ? (pk2(-m_run, 0.f) & 0xffffu) : 0u, 0u, 0u, 0u};
    asm volatile("" : "+v"(kaug.x), "+v"(kaug.y), "+v"(kaug.z), "+v"(kaug.w));
    for (int t = 1; t < nkt; ++t) {
        if ((t & 1) == 0) { const int s2 = vs + 2 >= 5 ? vs - 3 : vs + 2, s3 = vs + 3 >= 5 ? vs - 2 : vs + 3; if (t + 2 < nkt) { ATT_DMA_K(t + 2); ATT_DMA_K(t + 3); ATT_DMA_V(t + 2, s3); } ATT_DMA_V(t + 1, s2); }
        ATP_START(24, 0); ATP_START(27, 4);
        const LAS unsigned char* Kb = lds + (t & 3) * 16384; const LAS unsigned char* Vb = lds + 65536 + vs * 16384;
        bf16x8 kf[4]; s16x4 va[4], vb[4];
#pragma unroll
        for (int d0 = 0; d0 < 4; ++d0) kf[d0] = *(const LAS bf16x8*)(Kb + kbo[d0]);
        ATT_VLOAD(va, Vb, 0, 0);
        ATT_SB();
        p0 = __builtin_amdgcn_mfma_f32_32x32x16_bf16(__builtin_bit_cast(bf16x8, kaug), __builtin_bit_cast(bf16x8, qaug), (f32x16){0.f}, 0, 0, 0);
#pragma unroll
        for (int d0 = 0; d0 < 4; ++d0) p0 = __builtin_amdgcn_mfma_f32_32x32x16_bf16(kf[d0], qr[d0], p0, 0, 0, 0);
#pragma unroll
        for (int d0 = 0; d0 < 4; ++d0) kf[d0] = *(const LAS bf16x8*)(Kb + kbo[d0] + 8192);
        ATT_VLOAD(vb, Vb, 0, 1);
        ATT_SB();
        p1 = __builtin_amdgcn_mfma_f32_32x32x16_bf16(__builtin_bit_cast(bf16x8, kaug), __builtin_bit_cast(bf16x8, qaug), (f32x16){0.f}, 0, 0, 0);
#pragma unroll
        for (int d0 = 0; d0 < 4; ++d0) p1 = __builtin_amdgcn_mfma_f32_32x32x16_bf16(kf[d0], qr[d0], p1, 0, 0, 0);
        ATT_SB();
        ATT_PV1(va, 0, 0); ATT_PV1(va, 0, 1);
        ATT_VLOAD(va, Vb, 1, 0);
        ATT_SB();
        ATT_PV1(vb, 0, 2); ATT_PV1(vb, 0, 3);
        ATT_SB();
        ATP_STOP(24, 0); ATP_STOP(27, 4);
        ATP_START(23, 4);
        if (mp == 1 && (t & 1)) { asm volatile("s_waitcnt vmcnt(0)\n\ts_barrier" ::: "memory"); }
        ATP_STOP(23, 4); ATP_START(25, 0);
        float ls = 0.f, e0[16], e1[16];
        ATT_VLOAD(vb, Vb, 1, 1);
        ATT_PV1(va, 1, 0); ATT_EXP4(e0, p0, 0); ATT_PV1(va, 1, 1); ATT_EXP4(e0, p0, 4);
        ATT_SB();
        ATT_VLOAD(va, Vb, 2, 0);
        ATT_PV1(vb, 1, 2); ATT_EXP4(e0, p0, 8); ATT_PV1(vb, 1, 3); ATT_EXP4(e0, p0, 12);
        ATT_SB();
        ATT_VLOAD(vb, Vb, 2, 1);
        ATT_PV1(va, 2, 0); ATT_EXP2(e1, p1, 0); ATT_PV1(va, 2, 1); ATT_EXP2(e1, p1, 2);
        ATT_SB();
        ATT_VLOAD(va, Vb, 3, 0);
        ATT_PV1(vb, 2, 2); ATT_EXP2(e1, p1, 4); ATT_PV1(vb, 2, 3); ATT_EXP2(e1, p1, 6);
        ATT_SB();
        ATT_VLOAD(vb, Vb, 3, 1);
        ATT_PV1(va, 3, 0); ATT_EXP2(e1, p1, 8); ATT_PV1(va, 3, 1); ATT_EXP2(e1, p1, 10);
        ATT_SB();
        ATT_PV1(vb, 3, 2); ATT_EXP2(e1, p1, 12); ATT_PV1(vb, 3, 3); ATT_EXP2(e1, p1, 14);
        ATT_SB();
        if (__any(!(ls < ATT_BIG))) {
            const bf16* Kt = K + (rowbase + (size_t)(64 * t) + r32) * 1024 + h * 128 + mp * 64 + hi * 8;
            p0 = __builtin_amdgcn_mfma_f32_32x32x16_bf16(__builtin_bit_cast(bf16x8, kaug), __builtin_bit_cast(bf16x8, qaug), (f32x16){0.f}, 0, 0, 0); p1 = p0;
#pragma unroll
            for (int d0 = 0; d0 < 4; ++d0) { const bf16x8 a0 = *(const bf16x8*)(Kt + d0 * 16), a1 = *(const bf16x8*)(Kt + 32 * 1024 + d0 * 16);
                p0 = __builtin_amdgcn_mfma_f32_32x32x16_bf16(a0, qr[d0], p0, 0, 0, 0); p1 = __builtin_amdgcn_mfma_f32_32x32x16_bf16(a1, qr[d0], p1, 0, 0, 0); }
            float mx; ATT_ROWMAX(mx);
            const float mn = bflo(pk2(m_run + fmaxf(mx, 0.f), 0.f)), dl = mn - m_run, al = __builtin_amdgcn_exp2f(-dl);
            m_run = mn; l_run *= al; qaug.x = (hi == 0) ? (pk2(-mn, 0.f) & 0xffffu) : 0u;
#pragma unroll
            for (int c = 0; c < 4; ++c)
#pragma unroll
                for (int r = 0; r < 16; ++r) o[c][r] *= al;
            ls = 0.f;
#pragma unroll
            for (int r = 0; r < 16; ++r) { e0[r] = __builtin_amdgcn_exp2f(p0[r] - dl); e1[r] = __builtin_amdgcn_exp2f(p1[r] - dl); ls += e0[r] + e1[r]; }
        }
        l_run += ls;
        pw[0] = (v4u){cvtpk(e0[0], e0[1]), cvtpk(e0[2], e0[3]), cvtpk(e0[4], e0[5]), cvtpk(e0[6], e0[7])}; pw[1] = (v4u){cvtpk(e0[8], e0[9]), cvtpk(e0[10], e0[11]), cvtpk(e0[12], e0[13]), cvtpk(e0[14], e0[15])};
        pw[2] = (v4u){cvtpk(e1[0], e1[1]), cvtpk(e1[2], e1[3]), cvtpk(e1[4], e1[5]), cvtpk(e1[6], e1[7])}; pw[3] = (v4u){cvtpk(e1[8], e1[9]), cvtpk(e1[10], e1[11]), cvtpk(e1[12], e1[13]), cvtpk(e1[14], e1[15])};
        ATP_STOP(25, 0); ATP_START(22, 0);
        if (mp == 0 && (t & 1)) { asm volatile("s_waitcnt vmcnt(0)\n\ts_barrier" ::: "memory"); }
        ATP_STOP(22, 0);
        vs = (vs == 4) ? 0 : vs + 1;
    }
    ATP_STOP(21, 0); ATP_START(29, 0);
    unsigned nx_ = 0; if (tid == 0) nx_ = __hip_atomic_fetch_add(head, 1u, RLX_AGENT);
#undef ATT_VLOAD
#undef ATT_PV1
#undef ATT_EXP2
#undef ATT_EXP4
#undef ATT_SB
    { const LAS unsigned char* Vb = lds + 65536 + vs * 16384;
#pragma unroll
      for (int c = 0; c < 4; ++c)
#pragma unroll
          for (int s = 0; s < 4; ++s) ATT_PVSTEP(Vb, c, s); }
    __syncthreads();
#undef ATT_DMA_K
#undef ATT_DMA_V
#undef ATT_DMA1
#undef ATT_DMA_WAIT
#undef ATT_QK
#undef ATT_ROWMAX
#undef ATT_MAX3
#undef ATT_PVSTEP
    l_run += __shfl_xor(l_run, 32);
    const float inv = 1.0f / l_run;
    LAS float* X = (LAS float*)lds;
    if (mp == 1) {
#pragma unroll
        for (int c = 0; c < 4; ++c)
#pragma unroll
            for (int r = 0; r < 16; ++r) X[((qs * 4 + c) * 16 + r) * 64 + lane] = o[c][r] * inv;
    }
    __syncthreads();
    if (mp == 0) {
        int lo_ = l; asm volatile("" : "+s"(lo_));
        const float lam = ((const float*)(ws_ + WS_MISC))[l]; const float osc = 1.0f - (0.8f - 0.6f * __expf(-0.3f * (float)lo_));
        float ss = 0.f;
#pragma unroll
        for (int c = 0; c < 4; ++c)
#pragma unroll
            for (int r = 0; r < 16; ++r) { const float v = o[c][r] * inv - lam * X[((qs * 4 + c) * 16 + r) * 64 + lane]; o[c][r] = v; ss += v * v; }
        ss += __shfl_xor(ss, 32);
        const float rstd = rsqrtf(ss * (1.f / 128.f) + EPS) * osc; const float* gs = gsub + l * 128;
#pragma unroll
        for (int ch = 0; ch < 4; ch += 2) {
            asm volatile("" ::: "memory");
            f32x4 gq[2][4];
#pragma unroll
            for (int c = 0; c < 2; ++c)
#pragma unroll
                for (int rg = 0; rg < 4; ++rg) gq[c][rg] = *(const f32x4*)(gs + 32 * (ch + c) + 8 * rg + 4 * hi);
            asm volatile("" ::: "memory");
#pragma unroll
            for (int c2 = 0; c2 < 2; ++c2)
#pragma unroll
                for (int rg = 0; rg < 4; ++rg) { const int c = ch + c2, dv = 32 * c + 8 * rg + 4 * hi; const f32x4 g4 = gq[c2][rg];
                    v2u w; w.x = pk2(o[c][4 * rg] * rstd * g4.x, o[c][4 * rg + 1] * rstd * g4.y); w.y = pk2(o[c][4 * rg + 2] * rstd * g4.z, o[c][4 * rg + 3] * rstd * g4.w);
                    *(v2u*)(AR + qrow * 2048 + h * 128 + dv) = w; }
        }
    }
    if (tid == 0) misc[0] = nx_;
    __syncthreads();
    const int unext_ = __builtin_amdgcn_readfirstlane((int)misc[0]);
    ATP_STOP(26, 0); ATP_STOP(29, 0);
    if (PROBE_CLASS >= 21 && PROBE_CLASS <= 29 && blockIdx.x == 0 && lane == 0 && tp_acc != 0) __hip_atomic_fetch_add((unsigned long long*)(ws_ + (size_t)CW_PROBE * 4), tp_acc, __ATOMIC_RELAXED, __HIP_MEMORY_SCOPE_AGENT);
#undef ATP_START
#undef ATP_STOP
    return unext_;
}

constexpr int RP_UNITS = 512;
__device__ __forceinline__ void phase_mixer(unsigned char* ws_, const float* gsub, const float* grec, int l, int g, LAS unsigned char* lds, volatile LAS unsigned* misc, int tid, int rep) {
    unsigned* head = (unsigned*)(ws_ + WS_CTL) + CW_QUEUE + 64 * (l * NGRP + g + 4 * rep);
    unsigned* sdone = (unsigned*)(ws_ + WS_CTL) + CW_SCAN + 64 * (l * NGRP + g);
    const int nscan = NBG * 8 * 2, nqb = (l == 0) ? 18 : 16, natt = NBG * 8 * nqb;
    const int nrp_rows = (l == NLAYER - 1) ? NBG * SEQ : GT, rp_chunk = nrp_rows / RP_UNITS;
    const int lane = tid & 63, wave = __builtin_amdgcn_readfirstlane(tid >> 6);
    bool scan_pending = false;
    int unext = -1;
    for (;;) {
        int u;
        if (unext >= 0) { u = unext; unext = -1; } else {
        asm volatile("s_waitcnt vmcnt(0)" ::: "memory");
        __syncthreads();
        if (tid == 0) {
            if (scan_pending) { __builtin_amdgcn_fence(__ATOMIC_RELEASE, "agent"); asm volatile("s_waitcnt vmcnt(0)" ::: "memory"); __hip_atomic_fetch_add(sdone, 1u, RLX_AGENT); }
            misc[0] = __hip_atomic_fetch_add(head, 1u, RLX_AGENT);
        }
        __syncthreads();
        u = __builtin_amdgcn_readfirstlane((int)misc[0]);
        __syncthreads();
        scan_pending = false; }
        if (u >= nscan + natt + RP_UNITS) break;
        unsigned char* wsu = ws_; const float* gsub_u = gsub; const float* grec_u = grec; asm volatile("" : "+s"(wsu), "+s"(gsub_u), "+s"(grec_u));
        if (u < nscan) {
            if (SCAN_MFMA == 2) scan_unit_pipe(wsu, lds, tid, l, u >> 4, (u >> 1) & 7, u & 1); else if (SCAN_MFMA) { for (int rs_ = 0; rs_ < REP_SCAN; ++rs_) scan_unit_mfma(wsu, lds, tid, l, u >> 4, (u >> 1) & 7, u & 1); } else scan_unit(wsu, lds, tid, u >> 4, (u >> 1) & 7, u & 1);
            scan_pending = true;
        } else if (u < nscan + natt) { const int v = u - nscan; const int nbig = NBG * 8 * 16; int bh, qb; if (v < nbig) { bh = v >> 4; qb = 2 + (v & 15); } else { const int w = v - nbig; bh = w >> 1; qb = w & 1; }
            unext = attn_unit(wsu, gsub_u, lds, tid, l, bh >> 3, bh & 7, qb, head, misc); }
        else {
            if (tid == 0) { unsigned sp = 0; while (__hip_atomic_load(sdone, RLX_AGENT) < (unsigned)nscan) { __builtin_amdgcn_s_sleep(2); if (++sp > (1u << 20)) break; }
                __builtin_amdgcn_fence(__ATOMIC_ACQUIRE, "agent"); asm volatile("s_waitcnt vmcnt(0)" ::: "memory"); }
            __syncthreads();
            const int c = u - nscan - natt;
            rprep_range(wsu, grec_u, l, c * rp_chunk + wave, (c + 1) * rp_chunk, NWAVES, lane);
        }
    }
    asm volatile("s_waitcnt vmcnt(0)" ::: "memory");
}

#ifndef MK_SINGLE
#define MK_SINGLE 1
#endif
#ifndef REP_MIXER
#define REP_MIXER 1
#endif
#ifndef REP_GEMM
#define REP_GEMM 1
#endif
#ifndef REP_THIN
#define REP_THIN 1
#endif
#ifndef REP_X
#define REP_X 1
#endif
#ifndef REP_OUT
#define REP_OUT 1
#endif
#ifndef REP_MOE
#define REP_MOE 1
#endif
constexpr int PH_PER_GROUP = 9;
constexpr int N_PHASES = 1 + 1 + NLAYER * NGRP * (PH_PER_GROUP - 1);

__global__ void __launch_bounds__(NTHREADS, 2) fwd_kernel(Args args) {
    extern __shared__ __attribute__((aligned(16))) unsigned char lds_raw[];
    LAS unsigned char* lds = (LAS unsigned char*)lds_raw;
    volatile LAS unsigned* MISC = (volatile LAS unsigned*)(lds + MISC_OFF);
    const int G = gridDim.x, bx = blockIdx.x, vcu = (G % 8 == 0) ? (bx % 8) * (G / 8) + bx / 8 : bx;
    const int ngw = G * NWAVES;
#define IDS() int tid_ = threadIdx.x; asm volatile("" : "+v"(tid_)); const int tid = tid_, lane = tid & 63, wave = __builtin_amdgcn_readfirstlane(tid >> 6), gw = vcu * NWAVES + wave; (void)lane; (void)gw; (void)wave
#if defined(__HIP_DEVICE_COMPILE__)
#define KA() const __attribute__((address_space(4))) Args* kap_ = (const __attribute__((address_space(4))) Args*)__builtin_amdgcn_kernarg_segment_ptr(); asm volatile("" : "+s"(kap_)); const Args la = *kap_; unsigned char* ws = la.ws; (void)ws
#else
#define KA() const Args la = args; unsigned char* ws = la.ws; (void)ws
#endif
    unsigned* ctl = (unsigned*)(args.ws + WS_CTL);
    for (int u = threadIdx.x; u < (LDS_BYTES - LDSCTL_OFF) / 4; u += NTHREADS) ((LAS unsigned*)(lds + LDSCTL_OFF))[u] = 0u;
    __syncthreads();
    const int lo = args.ph_lo, hi = args.ph_hi;
    XcdBarrier bar; bar.bar = ctl + CW_BAR; bar.x = 0; bar.st = nullptr;
    if (hi - lo > 1) bar = xcd_barrier_post(ctl + CW_BAR, MISC + 8);
#define IN(k) (lo <= (k) && (k) < hi)
#ifndef REP_BAR
#define REP_BAR 1
#endif
#define SEAM(k) do { if (IN(k) && IN((k) + 1)) { for (int rb_ = 0; rb_ < REP_BAR; ++rb_) xcd_barrier(bar); } } while (0)

#ifndef PROBE_CLASS
#define PROBE_CLASS 0
#endif
    unsigned long long t_acc = 0, t_0 = 0; (void)t_0;
#define TSTART(c) do { if (PROBE_CLASS == (c)) t_0 = __builtin_amdgcn_s_memrealtime(); } while (0)
#define TSTOP(c) do { if (PROBE_CLASS == (c)) t_acc += __builtin_amdgcn_s_memrealtime() - t_0; } while (0)
    int pid = 0;
    TSTART(6);
    if (IN(pid)) { KA(); for (int rep = 0; rep < REP_THIN; ++rep) { __syncthreads(); { IDS(); phase_prologue(la, lds, tid, G); } __syncthreads(); { IDS(); phase_weights(la, 0, lds, gw, ngw, wave, lane); } } }
    SEAM(pid); TSTOP(6); ++pid;

    for (int l = 0; l < NLAYER; ++l) {
        for (int g = 0; g < NGRP; ++g) {
            const int mode = (l == NLAYER - 1) ? 1 : 0;
            const bool first = (l == 0 && g == 0);
            const int fl_ = (g + 1 < NGRP) ? l : l + 1, fg_ = (g + 1 < NGRP) ? g + 1 : 0; const bool ftar = fl_ < NLAYER; bool fdone = false;
#define FILL() do { if (ftar && !fdone) { unsigned long long tf_ = 0; if (PROBE_CLASS == 12) tf_ = __builtin_amdgcn_s_memrealtime(); IDS(); fdone = fill_norm1(la, fl_, fg_, MISC, tid, wave, lane); if (PROBE_CLASS == 12) t_acc += __builtin_amdgcn_s_memrealtime() - tf_; } } while (0)
            TSTART(7);
            if (first) {
            if (IN(pid)) { KA(); for (int rep = 0; rep < REP_THIN; ++rep) { IDS(); phase_norm1(la, l, g, gw, ngw, lane); } }
            SEAM(pid); TSTOP(7); ++pid; }
            TSTART(2);
            if (IN(pid)) { KA();
                pg8::Gemm gm{(const bf16*)(ws + (first ? WS_AR : WS_HN)), (const bf16*)(ws + WS_WIN), GT, NIN, 1024};
                DenseOrder S; S.init((l == NLAYER - 1) ? 2 : 0, NIN / 256, G, bx);
                EpiInProj E{(bf16*)(ws + WS_PROJ), (const float*)(ws + WS_ROPE), (const float*)(ws + WS_ROPE) + 2048 * 32, (const float*)(ws + WS_MISC) + 256 + l * 1024, l == 0};
                for (int rep = 0; rep < REP_GEMM; ++rep) pg8::gemm_phase<EpiInProj, DenseOrder, true, true>(lds, gm, S, E);
                if (first) FILL();
            }
            SEAM(pid); TSTOP(2); ++pid;
            TSTART(1);
            if (IN(pid)) { KA(); for (int rep = 0; rep < REP_MIXER; ++rep) { IDS(); phase_mixer(la.ws, la.in[13], la.in[15], l, g, lds, MISC, tid, rep); } }
            SEAM(pid); TSTOP(1); ++pid;
            TSTART(3);
            if (IN(pid)) { KA();
                pg8::Gemm gm{(const bf16*)(ws + WS_AR), (const bf16*)(ws + WS_WAR), GT, 1024, 2048};
                DenseOrder S; S.init(mode, 4, G, bx);
                EpiMix E{(const bf16*)(ws + WS_PROJ) + 8 * SEG_ELEMS, (const bf16*)(ws + WS_PROJ) + 9 * SEG_ELEMS, (bf16*)(ws + WS_MIX)};
                for (int rep = 0; rep < REP_GEMM; ++rep) pg8::gemm_phase<EpiMix, DenseOrder, true, true>(lds, gm, S, E);
                FILL();
            }
            SEAM(pid); TSTOP(3); ++pid;
            TSTART(3);
            if (IN(pid)) { KA();
                pg8::Gemm gm{(const bf16*)(ws + WS_MIX), (const bf16*)(ws + WS_WO), GT, 1024, 1024};
                DenseOrder S; S.init(mode, 4, G, bx);
                for (int rep = REP_OUT - 1; rep >= 0; --rep) {
                EpiOut E{(l == 0) ? la.in[0] : la.out, rep ? ((float*)(ws + WS_DUMMY) - (size_t)g * NBG * SEQ * 1024) : la.out, (l == 0) ? la.in[2] : (const float*)(ws + WS_XC), rep ? ((float*)(ws + WS_DUMMY + 64 * MiB) - (size_t)g * NBG * CTXL * 1024) : (float*)(ws + WS_XC), (const float*)(ws + WS_MOD) + (size_t)l * 17 * 6144, g * NBG};
                pg8::gemm_phase<EpiOut, DenseOrder, true, true>(lds, gm, S, E); }
                FILL();
            }
            SEAM(pid); TSTOP(3); ++pid;
            TSTART(9);
            if (IN(pid)) { KA(); for (int rep = REP_X - 1; rep >= 0; --rep) { __syncthreads(); IDS(); phase_route(la, l, g, lds, tid, gw, ngw, lane, rep); } }
            SEAM(pid); TSTOP(9); ++pid;
            TSTART(4);
            if (IN(pid)) { KA();
                int t0_ = threadIdx.x; asm volatile("" : "+v"(t0_));
                const int nt = moe_tables(ws, l, g, lds, t0_);
                pg8::Gemm gm{(const bf16*)(ws + WS_H2S), (const bf16*)(ws + WS_WUP), GT, 2048, 1024};
                LAS int* tl = (LAS int*)(lds + TILE_OFF); LAS int* gl = (LAS int*)(lds + GIDX_OFF);
                MoeOrder<8, true> S; S.init(tl, nt, G, vcu, gl);
                { const LAS int* cn = (const LAS int*)(lds + MOECN_OFF); const LAS int* ex = (const LAS int*)(lds + MOEEX_OFF); const int* list = (const int*)(ws + WS_LIST);
                  pg8::Unit uu;
                  for (int ui = 0; ui < GIDX_UNITS && S.next(ui, uu); ++ui) if (t0_ < 256) { const int e = tl[uu.pm], pos = 256 * (uu.pm - (ex[e] >> 8)) + t0_; gl[ui * 256 + t0_] = (pos < cn[e]) ? ldg_i(list + e * GT + pos) : 0; } }
                __syncthreads();
                EpiUp E{(bf16*)(ws + WS_HID)};
                for (int rep = 0; rep < REP_MOE; ++rep) pg8::gemm_phase<EpiUp, MoeOrder<8, true>, true, true>(lds, gm, S, E);
            }
            SEAM(pid); TSTOP(4); ++pid;
            TSTART(4);
            if (IN(pid)) { KA();
                int t0_ = threadIdx.x; asm volatile("" : "+v"(t0_));
                const int nt = moe_tables(ws, l, g, lds, t0_);
                pg8::Gemm gm{(const bf16*)(ws + WS_HID), (const bf16*)(ws + WS_WDN), MAXSLOT, 1024, 1024};
                LAS int* tl = (LAS int*)(lds + TILE_OFF);
                MoeOrder<4> S; S.init(tl, nt, G, vcu);
                EpiDown E{(bf16*)(ws + WS_YE)};
                for (int rep = 0; rep < REP_MOE; ++rep) pg8::gemm_phase<EpiDown, MoeOrder<4>, true, true>(lds, gm, S, E);
                FILL();
            }
            SEAM(pid); TSTOP(4); ++pid;
            TSTART(11);
            if (IN(pid)) { KA();
                for (int rep = REP_X - 1; rep >= 0; --rep) { IDS(); phase_combine(la, l, g, gw, ngw, lane, rep); }
                FILL();
                if (l + 1 < NLAYER && g == NGRP - 1) { for (int rep = 0; rep < REP_THIN; ++rep) { IDS(); phase_weights(la, l + 1, lds, gw, ngw, wave, lane); } }
            }
            SEAM(pid); TSTOP(11); ++pid;
#undef FILL
        }
    }
    if (((PROBE_CLASS >= 21 && PROBE_CLASS <= 29) || (PROBE_CLASS >= 13 && PROBE_CLASS <= 15)) && blockIdx.x == 0) { __syncthreads(); KA(); t_acc = __hip_atomic_load((const unsigned long long*)(ws + (size_t)CW_PROBE * 4), __ATOMIC_RELAXED, __HIP_MEMORY_SCOPE_AGENT); }
    if (PROBE_CLASS != 0 && blockIdx.x == 0) { const unsigned long long te = __builtin_amdgcn_s_memrealtime(); while (__builtin_amdgcn_s_memrealtime() - te < t_acc) __builtin_amdgcn_s_sleep(8); }
#undef IN
#undef SEAM
}

extern "C" void kernel_launch(void* const* d_in, const int* in_sizes, int n_in, void* d_out, int out_size, void* d_ws, size_t ws_size, hipStream_t stream) {
    static int grid = 0;
    if (grid == 0) {
        if (n_in != 25 || out_size != NBATCH * SEQ * D || ws_size < WS_END) { fprintf(stderr, "kernel_launch: unexpected shapes (n_in %d out %d ws %zu need %zu)\n", n_in, out_size, ws_size, (size_t)WS_END); grid = -1; return; }
        int dev = 0, cus = 0, per_cu = 0;
        if (hipGetDevice(&dev) != hipSuccess || hipDeviceGetAttribute(&cus, hipDeviceAttributeMultiprocessorCount, dev) != hipSuccess) { grid = -1; return; }
        if (hipFuncSetAttribute((const void*)fwd_kernel, hipFuncAttributeMaxDynamicSharedMemorySize, LDS_BYTES) != hipSuccess) { fprintf(stderr, "kernel_launch: hipFuncSetAttribute failed\n"); grid = -1; return; }
        if (hipOccupancyMaxActiveBlocksPerMultiprocessor(&per_cu, (const void*)fwd_kernel, NTHREADS, LDS_BYTES) != hipSuccess || per_cu < 1) { fprintf(stderr, "kernel_launch: occupancy query says %d blocks per CU\n", per_cu); }
        (void)hipGetLastError();
        grid = cus;
    }
    if (grid < 0) return;
    if (hipMemsetAsync((char*)d_ws + WS_CTL, 0, CTL_ZERO_BYTES, stream) != hipSuccess) return;
    Args a{};
    for (int i = 0; i < 25; ++i) a.in[i] = (const float*)d_in[i];
    a.out = (float*)d_out; a.ws = (unsigned char*)d_ws;
#if MK_SINGLE
    a.ph_lo = 0; a.ph_hi = N_PHASES;
    hipLaunchKernelGGL(fwd_kernel, dim3(grid), dim3(NTHREADS), LDS_BYTES, stream, a);
#else
    for (int p = 0; p < N_PHASES; ++p) { a.ph_lo = p; a.ph_hi = p + 1; hipLaunchKernelGGL(fwd_kernel, dim3(grid), dim3(NTHREADS), LDS_BYTES, stream, a); }
#endif
}
```
